# Optimizing an MI355X kernel written in HIP

```python
import jax
import jax.numpy as jnp
from jax import lax
import numpy as np

D_MODEL = 1024
BATCH = 2
SEQ = 16384
DEPTH = 4

N_MIXERS = 4
ALPHA = (2 * DEPTH) ** 0.25
BETA = (8 * DEPTH) ** -0.25
LN_EPS = 1e-5
D_FF = 2816
FFN_HALF = 0.5

RET_HEADS = 4
RET_DK = D_MODEL // RET_HEADS
RET_DV = 2 * RET_DK
RET_CHUNK = 128
ROPE_BASE = 10000.0
RET_GN_EPS = 1e-5

S5_WIDTH = D_MODEL
S5_GROUP = 16
S5_GROUPS = S5_WIDTH // S5_GROUP
S5_STATE = 64
S5_CHUNK = 128
S5_DT_MIN = 1e-3
S5_DT_MAX = 1e-1

RW_HEAD = 64
RW_HEADS = D_MODEL // RW_HEAD
RW_DECAY_LORA = 64
RW_AAA_LORA = 64
RW_GATE_LORA = 128
RW_GN_EPS = 64e-5
RW_N_MIX = 6

LRU_WIDTH = D_MODEL
LRU_BLOCKS = 4
LRU_BLOCK = LRU_WIDTH // LRU_BLOCKS
CONV_WIDTH = 4
LRU_C = 8.0
LRU_A_MIN = 0.9
LRU_A_MAX = 0.999

kernel_name = 'hybrid_ret_s5_rwkv7_rglru_trunk'


def _n_occ(m):
    return len(range(m, DEPTH, N_MIXERS))


def layer_norm(x, g, b):
    xf = x.astype(jnp.float32)
    mu = jnp.mean(xf, -1, keepdims=True)
    var = jnp.mean(jnp.square(xf - mu), -1, keepdims=True)
    return ((xf - mu) * lax.rsqrt(var + LN_EPS) * g + b).astype(x.dtype)


def head_norm(y, eps):
    mu = jnp.mean(y, -1, keepdims=True)
    var = jnp.mean(jnp.square(y - mu), -1, keepdims=True)
    return (y - mu) * lax.rsqrt(var + eps)


def swiglu(x, w1, w3, w2):
    return (jax.nn.silu(x @ w1) * (x @ w3)) @ w2


def rotary(t):
    T, d = t.shape[1], t.shape[-1]
    half = d // 2
    inv = ROPE_BASE ** (-jnp.arange(half, dtype=jnp.float32) / half)
    ang = jnp.arange(T, dtype=jnp.float32)[:, None] * inv[None, :]
    cos = jnp.cos(ang)[None, :, None, :]
    sin = jnp.sin(ang)[None, :, None, :]
    t1, t2 = t[..., :half], t[..., half:]
    return jnp.concatenate([t1 * cos - t2 * sin, t1 * sin + t2 * cos], axis=-1)


def retention(x, w_in, w_out):
    B, T, _ = x.shape
    H, DK, DV, C = RET_HEADS, RET_DK, RET_DV, RET_CHUNK
    nc = T // C
    q, k, v, g = jnp.split(x @ w_in, [H * DK, 2 * H * DK, 2 * H * DK + H * DV], axis=-1)
    q = rotary(q.reshape(B, T, H, DK).astype(jnp.float32))
    k = rotary(k.reshape(B, T, H, DK).astype(jnp.float32)) * (DK ** -0.5)
    v = v.reshape(B, T, H, DV).astype(jnp.float32)
    log_gamma = jnp.log1p(-jnp.power(2.0, -5.0 - jnp.arange(H, dtype=jnp.float32)))
    pos = jnp.arange(C, dtype=jnp.float32)
    rel = pos[:, None] - pos[None, :]
    inner_decay = jnp.where(rel >= 0, jnp.exp(jnp.maximum(rel, 0.0)[None] * log_gamma[:, None, None]), 0.0)
    q_decay = jnp.exp((pos + 1.0)[:, None] * log_gamma)[..., None]
    k_decay = jnp.exp((C - 1.0 - pos)[:, None] * log_gamma)[..., None]
    chunk_decay = jnp.exp(C * log_gamma)[:, None, None]

    def to_chunks(t):
        return t.reshape(B, nc, C, H, t.shape[-1]).swapaxes(0, 1)

    def chunk_step(R, qkv):
        qc, kc, vc = qkv
        s = jnp.einsum('bihd,bjhd->bhij', qc, kc) * inner_decay
        inner = jnp.einsum('bhij,bjhe->bihe', s, vc)
        cross = jnp.einsum('bihd,bhde->bihe', qc * q_decay, R)
        R = R * chunk_decay + jnp.einsum('bjhd,bjhe->bhde', kc * k_decay, vc)
        return R, inner + cross

    R0 = jnp.zeros((B, H, DK, DV), jnp.float32)
    _, o = lax.scan(chunk_step, R0, (to_chunks(q), to_chunks(k), to_chunks(v)))
    o = head_norm(o.swapaxes(0, 1).reshape(B, T, H, DV), RET_GN_EPS).reshape(B, T, H * DV)
    o = jax.nn.silu(g.astype(jnp.float32)) * o
    return o.astype(x.dtype) @ w_out


def _complex_combine(e1, e2):
    a1r, a1i, b1r, b1i = e1
    a2r, a2i, b2r, b2i = e2
    return (a2r * a1r - a2i * a1i,
            a2r * a1i + a2i * a1r,
            a2r * b1r - a2i * b1i + b2r,
            a2r * b1i + a2i * b1r + b2i)


def s5_mixer(x, w_in, a_re, a_im, b_re, b_im, c_re, c_im, d_skip, log_step, w_glu, w_out):
    B, T, _ = x.shape
    G, P, N, C = S5_GROUPS, S5_GROUP, S5_STATE, S5_CHUNK
    nc = T // C
    f32 = jnp.float32
    a_re, a_im = a_re.astype(f32), a_im.astype(f32)
    b_re, b_im = b_re.astype(f32), b_im.astype(f32)
    c_re, c_im = c_re.astype(f32), c_im.astype(f32)
    u = (x @ w_in).astype(f32)
    dt = jnp.exp(log_step.astype(f32))[:, None]
    mag = jnp.exp(dt * a_re)
    abar_re = mag * jnp.cos(dt * a_im)
    abar_im = mag * jnp.sin(dt * a_im)
    den = a_re * a_re + a_im * a_im
    f_re = ((abar_re - 1.0) * a_re + abar_im * a_im) / den
    f_im = (abar_im * a_re - (abar_re - 1.0) * a_im) / den
    bb_re = f_re[..., None] * b_re - f_im[..., None] * b_im
    bb_im = f_re[..., None] * b_im + f_im[..., None] * b_re
    a_blk_re = jnp.broadcast_to(abar_re, (B, C, G, N))
    a_blk_im = jnp.broadcast_to(abar_im, (B, C, G, N))

    def chunk_step(h, u_blk):
        h_re, h_im = h
        bu_re = jnp.einsum('bcgp,gnp->bcgn', u_blk, bb_re)
        bu_im = jnp.einsum('bcgp,gnp->bcgn', u_blk, bb_im)
        p_re, p_im, s_re, s_im = lax.associative_scan(
            _complex_combine, (a_blk_re, a_blk_im, bu_re, bu_im), axis=1)
        st_re = p_re * h_re[:, None] - p_im * h_im[:, None] + s_re
        st_im = p_re * h_im[:, None] + p_im * h_re[:, None] + s_im
        y = jnp.einsum('bcgn,gpn->bcgp', st_re, c_re) - jnp.einsum('bcgn,gpn->bcgp', st_im, c_im)
        return (st_re[:, -1], st_im[:, -1]), y

    h0 = (jnp.zeros((B, G, N), f32), jnp.zeros((B, G, N), f32))
    u_chunks = u.reshape(B, nc, C, G, P).swapaxes(0, 1)
    _, y = lax.scan(chunk_step, h0, u_chunks)
    y = y.swapaxes(0, 1).reshape(B, T, G * P) + d_skip.astype(f32) * u
    act = jax.nn.gelu(y).astype(x.dtype)
    z = act * jax.nn.sigmoid(act @ w_glu)
    return z @ w_out


def rwkv7_mixer(x, mu, w_r, w_k, w_v, w0, w1, w2, a0, a1, a2, g1, g2,
                k_k, k_a, r_k, lnx_g, lnx_b, w_o):
    B, T, D = x.shape
    H, N = RW_HEADS, RW_HEAD
    f32 = jnp.float32
    xx = jnp.pad(x, ((0, 0), (1, 0), (0, 0)))[:, :-1] - x
    xr, xw, xk, xv, xa, xg = (x + xx * mu[i] for i in range(RW_N_MIX))
    r = (xr @ w_r).astype(f32)
    k = (xk @ w_k).astype(f32)
    v = (xv @ w_v).astype(f32)
    w = -jax.nn.softplus(-(w0 + jnp.tanh(xw @ w1) @ w2).astype(f32)) - 0.5
    decay = jnp.exp(-jnp.exp(w))
    a = jax.nn.sigmoid((a0 + (xa @ a1) @ a2).astype(f32))
    g = (jax.nn.sigmoid(xg @ g1) @ g2).astype(f32)
    heads = lambda t: t.reshape(B, T, H, N)
    r, k, v, decay, a = heads(r), heads(k), heads(v), heads(decay), heads(a)
    kk = k * k_k.astype(f32).reshape(H, N)
    kk = kk / jnp.maximum(jnp.sqrt(jnp.sum(kk * kk, -1, keepdims=True)), 1e-12)
    k = k * (1.0 + (a - 1.0) * k_a.astype(f32).reshape(H, N))

    def step(S, inp):
        r_t, w_t, k_t, v_t, kk_t, a_t = inp
        sa = jnp.einsum('bhvk,bhk->bhv', S, -kk_t)
        S = (S * w_t[:, :, None, :] + sa[..., None] * (kk_t * a_t)[:, :, None, :]
             + v_t[..., None] * k_t[:, :, None, :])
        return S, jnp.einsum('bhvk,bhk->bhv', S, r_t)

    xs = tuple(t.swapaxes(0, 1) for t in (r, decay, k, v, kk, a))
    S0 = jnp.zeros((B, H, N, N), f32)
    _, y = lax.scan(step, S0, xs)
    y = y.swapaxes(0, 1)
    y = head_norm(y, RW_GN_EPS) * lnx_g.astype(f32).reshape(H, N) + lnx_b.astype(f32).reshape(H, N)
    y = y + jnp.sum(r * k * r_k.astype(f32), -1, keepdims=True) * v
    y = (y.reshape(B, T, D) * g).astype(x.dtype)
    return y @ w_o


def _real_combine(e1, e2):
    a1, b1 = e1
    a2, b2 = e2
    return a2 * a1, a2 * b1 + b2


def rglru_block(x, w_in, conv_w, conv_b, w_a, b_a, w_x, b_x, lam, w_out):
    B, T, _ = x.shape
    f32 = jnp.float32
    gate, xr = jnp.split(x @ w_in, 2, axis=-1)
    gate = jax.nn.gelu(gate)
    xr = lax.conv_general_dilated(
        xr, conv_w.astype(xr.dtype)[:, None, :], window_strides=(1,),
        padding=[(CONV_WIDTH - 1, 0)], dimension_numbers=('NWC', 'WIO', 'NWC'),
        feature_group_count=LRU_WIDTH) + conv_b
    xb = xr.reshape(B, T, LRU_BLOCKS, LRU_BLOCK)
    gr = jnp.einsum('btki,kij->btkj', xb, w_a).reshape(B, T, LRU_WIDTH) + b_a
    gi = jnp.einsum('btki,kij->btkj', xb, w_x).reshape(B, T, LRU_WIDTH) + b_x
    r_t = jax.nn.sigmoid(gr.astype(f32))
    i_t = jax.nn.sigmoid(gi.astype(f32))
    log_a = -LRU_C * r_t * jax.nn.softplus(-lam.astype(f32))
    a_t = jnp.exp(log_a)
    inp = jnp.sqrt(-jnp.expm1(2.0 * log_a)) * (i_t * xr.astype(f32))
    _, h = lax.associative_scan(_real_combine, (a_t, inp), axis=1)
    y = (h * gate.astype(f32)).astype(x.dtype)
    return y @ w_out


def setup_inputs(seed: int = 0) -> dict:
    key = jax.random.key(seed)
    ks = iter(jax.random.split(key, 64))
    f32 = jnp.float32
    D = D_MODEL

    def nrm(shape, scale):
        return scale * jax.random.normal(next(ks), shape, f32)

    def unif(shape, lo, hi):
        return jax.random.uniform(next(ks), shape, f32, lo, hi)

    nA, nB, nC, nD = (_n_occ(m) for m in range(N_MIXERS))
    x = nrm((BATCH, SEQ, D), 1.0)
    ln_g = 1.0 + nrm((DEPTH, 3, D), 0.02)
    ln_b = nrm((DEPTH, 3, D), 0.02)
    ffn_w1 = nrm((DEPTH, 2, D, D_FF), D ** -0.5)
    ffn_w3 = nrm((DEPTH, 2, D, D_FF), D ** -0.5)
    ffn_w2 = nrm((DEPTH, 2, D_FF, D), BETA * D_FF ** -0.5)

    ret_w_in = nrm((nA, D, 2 * RET_HEADS * RET_DK + 2 * RET_HEADS * RET_DV), D ** -0.5)
    ret_w_out = nrm((nA, RET_HEADS * RET_DV, D), BETA * (RET_HEADS * RET_DV) ** -0.5)

    G, P, N = S5_GROUPS, S5_GROUP, S5_STATE
    s5_w_in = nrm((nB, D, S5_WIDTH), D ** -0.5)
    s5_a_re = -0.5 + nrm((nB, G, N), 0.01)
    s5_a_im = jnp.pi * jnp.arange(N, dtype=f32)[None, None, :] + nrm((nB, G, N), 0.01)
    s5_b_re = nrm((nB, G, N, P), (2 * P) ** -0.5)
    s5_b_im = nrm((nB, G, N, P), (2 * P) ** -0.5)
    s5_c_re = nrm((nB, G, P, N), N ** -0.5)
    s5_c_im = nrm((nB, G, P, N), N ** -0.5)
    s5_d = nrm((nB, S5_WIDTH), 1.0)
    s5_log_step = unif((nB, G), float(np.log(S5_DT_MIN)), float(np.log(S5_DT_MAX)))
    s5_w_glu = nrm((nB, S5_WIDTH, S5_WIDTH), S5_WIDTH ** -0.5)
    s5_w_out = nrm((nB, S5_WIDTH, D), BETA * S5_WIDTH ** -0.5)

    rw_mu = unif((nC, RW_N_MIX, D), 0.0, 1.0)
    rw_w_r = nrm((nC, D, D), D ** -0.5)
    rw_w_k = nrm((nC, D, D), D ** -0.5)
    rw_w_v = nrm((nC, D, D), D ** -0.5)
    decay_speed = -6.0 + 5.0 * (jnp.arange(D, dtype=f32) / (D - 1)) ** 0.85 + 0.5
    rw_w0 = decay_speed[None, :] + nrm((nC, D), 0.01)
    rw_w1 = nrm((nC, D, RW_DECAY_LORA), D ** -0.5)
    rw_w2 = nrm((nC, RW_DECAY_LORA, D), 0.1 * RW_DECAY_LORA ** -0.5)
    rw_a0 = nrm((nC, D), 0.1)
    rw_a1 = nrm((nC, D, RW_AAA_LORA), D ** -0.5)
    rw_a2 = nrm((nC, RW_AAA_LORA, D), 0.1 * RW_AAA_LORA ** -0.5)
    rw_g1 = nrm((nC, D, RW_GATE_LORA), D ** -0.5)
    rw_g2 = nrm((nC, RW_GATE_LORA, D), RW_GATE_LORA ** -0.5)
    rw_k_k = 0.85 + nrm((nC, D), 0.02)
    rw_k_a = 1.0 + nrm((nC, D), 0.02)
    rw_r_k = nrm((nC, RW_HEADS, RW_HEAD), 0.1)
    rw_lnx_g = 1.0 + nrm((nC, D), 0.02)
    rw_lnx_b = nrm((nC, D), 0.02)
    rw_w_o = nrm((nC, D, D), BETA * D ** -0.5)

    lru_w_in = nrm((nD, D, 2 * LRU_WIDTH), D ** -0.5)
    lru_conv_w = nrm((nD, CONV_WIDTH, LRU_WIDTH), CONV_WIDTH ** -0.5)
    lru_conv_b = nrm((nD, LRU_WIDTH), 0.02)
    lru_w_a = nrm((nD, LRU_BLOCKS, LRU_BLOCK, LRU_BLOCK), LRU_BLOCK ** -0.5)
    lru_b_a = nrm((nD, LRU_WIDTH), 0.02)
    lru_w_x = nrm((nD, LRU_BLOCKS, LRU_BLOCK, LRU_BLOCK), LRU_BLOCK ** -0.5)
    lru_b_x = nrm((nD, LRU_WIDTH), 0.02)
    p = unif((nD, LRU_WIDTH), LRU_A_MIN, LRU_A_MAX) ** (1.0 / LRU_C)
    lru_lambda = jnp.log(p) - jnp.log1p(-p)
    lru_w_out = nrm((nD, LRU_WIDTH, D), BETA * LRU_WIDTH ** -0.5)

    return {
        'x': x, 'ln_g': ln_g, 'ln_b': ln_b,
        'ffn_w1': ffn_w1, 'ffn_w3': ffn_w3, 'ffn_w2': ffn_w2,
        'ret_w_in': ret_w_in, 'ret_w_out': ret_w_out,
        's5_w_in': s5_w_in, 's5_a_re': s5_a_re, 's5_a_im': s5_a_im,
        's5_b_re': s5_b_re, 's5_b_im': s5_b_im, 's5_c_re': s5_c_re, 's5_c_im': s5_c_im,
        's5_d': s5_d, 's5_log_step': s5_log_step, 's5_w_glu': s5_w_glu, 's5_w_out': s5_w_out,
        'rw_mu': rw_mu, 'rw_w_r': rw_w_r, 'rw_w_k': rw_w_k, 'rw_w_v': rw_w_v,
        'rw_w0': rw_w0, 'rw_w1': rw_w1, 'rw_w2': rw_w2,
        'rw_a0': rw_a0, 'rw_a1': rw_a1, 'rw_a2': rw_a2,
        'rw_g1': rw_g1, 'rw_g2': rw_g2, 'rw_k_k': rw_k_k, 'rw_k_a': rw_k_a,
        'rw_r_k': rw_r_k, 'rw_lnx_g': rw_lnx_g, 'rw_lnx_b': rw_lnx_b, 'rw_w_o': rw_w_o,
        'lru_w_in': lru_w_in, 'lru_conv_w': lru_conv_w, 'lru_conv_b': lru_conv_b,
        'lru_w_a': lru_w_a, 'lru_b_a': lru_b_a, 'lru_w_x': lru_w_x, 'lru_b_x': lru_b_x,
        'lru_lambda': lru_lambda, 'lru_w_out': lru_w_out,
    }


def reference(x, ln_g, ln_b, ffn_w1, ffn_w3, ffn_w2, ret_w_in, ret_w_out,
              s5_w_in, s5_a_re, s5_a_im, s5_b_re, s5_b_im, s5_c_re, s5_c_im,
              s5_d, s5_log_step, s5_w_glu, s5_w_out,
              rw_mu, rw_w_r, rw_w_k, rw_w_v, rw_w0, rw_w1, rw_w2,
              rw_a0, rw_a1, rw_a2, rw_g1, rw_g2, rw_k_k, rw_k_a,
              rw_r_k, rw_lnx_g, rw_lnx_b, rw_w_o,
              lru_w_in, lru_conv_w, lru_conv_b, lru_w_a, lru_b_a, lru_w_x, lru_b_x,
              lru_lambda, lru_w_out):
    for i in range(DEPTH):
        m, j = i % N_MIXERS, i // N_MIXERS
        x = layer_norm(ALPHA * x + FFN_HALF * swiglu(x, ffn_w1[i, 0], ffn_w3[i, 0], ffn_w2[i, 0]),
                       ln_g[i, 0], ln_b[i, 0])
        if m == 0:
            y = retention(x, ret_w_in[j], ret_w_out[j])
        elif m == 1:
            y = s5_mixer(x, s5_w_in[j], s5_a_re[j], s5_a_im[j], s5_b_re[j], s5_b_im[j],
                         s5_c_re[j], s5_c_im[j], s5_d[j], s5_log_step[j], s5_w_glu[j], s5_w_out[j])
        elif m == 2:
            y = rwkv7_mixer(x, rw_mu[j], rw_w_r[j], rw_w_k[j], rw_w_v[j], rw_w0[j], rw_w1[j], rw_w2[j],
                            rw_a0[j], rw_a1[j], rw_a2[j], rw_g1[j], rw_g2[j], rw_k_k[j], rw_k_a[j],
                            rw_r_k[j], rw_lnx_g[j], rw_lnx_b[j], rw_w_o[j])
        else:
            y = rglru_block(x, lru_w_in[j], lru_conv_w[j], lru_conv_b[j], lru_w_a[j], lru_b_a[j],
                            lru_w_x[j], lru_b_x[j], lru_lambda[j], lru_w_out[j])
        x = layer_norm(ALPHA * x + y, ln_g[i, 1], ln_b[i, 1])
        x = layer_norm(ALPHA * x + FFN_HALF * swiglu(x, ffn_w1[i, 1], ffn_w3[i, 1], ffn_w2[i, 1]),
                       ln_g[i, 2], ln_b[i, 2])
    return x
```

```cpp
#include <hip/hip_runtime.h>
#include <hip/hip_cooperative_groups.h>
#include <cstdio>
namespace cg = cooperative_groups;

#define DEV __device__ __forceinline__
#define LAS __attribute__((address_space(3)))
typedef unsigned short bf16_t;
typedef short bf16x8 __attribute__((ext_vector_type(8)));
typedef float f32x4 __attribute__((ext_vector_type(4)));

constexpr int M_TOK = 32768, DM = 1024, DFF = 2816, TSEQ = 16384;
constexpr float ALPHA = 1.681792830507429f;
constexpr size_t UNIT = 64ull << 20;

DEV float bf2f(bf16_t b) { return __uint_as_float(((unsigned)b) << 16); }
DEV unsigned pack2(float a, float b) { unsigned r; asm("v_cvt_pk_bf16_f32 %0, %1, %2" : "=v"(r) : "v"(a), "v"(b)); return r; }
DEV bf16_t f2bf(float f) { return (bf16_t)pack2(f, f); }
DEV float sigmoidf_(float x) { return __builtin_amdgcn_rcpf(1.0f + __expf(-x)); }
DEV float siluf_(float x) { return x * __builtin_amdgcn_rcpf(1.0f + __expf(-x)); }
DEV float tanhf_(float x) { float e = __expf(-2.0f * fabsf(x)); float t = (1.0f - e) * __builtin_amdgcn_rcpf(1.0f + e); return x < 0.f ? -t : t; }
DEV float geluf_(float x) { return 0.5f * x * (1.0f + tanhf_(0.7978845608028654f * (x + 0.044715f * x * x * x))); }
DEV float softplus_neg(float l) { const float x = __expf(-l); return x < 0.03f ? x * (1.0f - x * (0.5f - x * (0.33333333f - 0.25f * x))) : (l < -15.f ? -l : __logf(1.0f + x)); }
DEV float neg_expm1(float y) { return y > -0.05f ? -y * (1.0f + y * (0.5f + y * (0.16666667f + y * 0.041666667f))) : 1.0f - __expf(y); }
DEV float wave_sum(float v) { for (int o = 32; o > 0; o >>= 1) v += __shfl_xor(v, o, 64); return v; }
template <int CTRL> DEV float dppf(float v) { return __int_as_float(__builtin_amdgcn_update_dpp(0, __float_as_int(v), CTRL, 0xF, 0xF, true)); }
DEV int otid_(int wv) { int t = wv * 64 + (int)__builtin_amdgcn_mbcnt_hi(~0u, __builtin_amdgcn_mbcnt_lo(~0u, 0u)); asm volatile("" : "+v"(t)); return t; }
#define otid() otid_(wid_s_)
DEV int obid() { int t = blockIdx.x; asm volatile("" : "+s"(t)); return t; }
DEV float sum16(float v) { v += dppf<0xB1>(v); v += dppf<0x4E>(v); v += dppf<0x141>(v); v += dppf<0x140>(v); return v; }
DEV float rdlane(float v, int l) { return __int_as_float(__builtin_amdgcn_readlane(__float_as_int(v), l)); }
DEV float wave_sum_fast(float v) { v = sum16(v); return (rdlane(v, 0) + rdlane(v, 16)) + (rdlane(v, 32) + rdlane(v, 48)); }

struct Params {
    const float* in[46];
    float* x;
    unsigned char* ws;
    int ph_lo, ph_hi;
};
typedef const __attribute__((address_space(4))) Params* CP;
enum { I_X, I_LNG, I_LNB, I_W1, I_W3, I_W2, I_RET_IN, I_RET_OUT, I_S5_IN, I_S5_ARE, I_S5_AIM, I_S5_BRE, I_S5_BIM, I_S5_CRE, I_S5_CIM, I_S5_D, I_S5_LS, I_S5_GLU, I_S5_OUT,
       I_RW_MU, I_RW_R, I_RW_K, I_RW_V, I_RW_W0, I_RW_W1, I_RW_W2, I_RW_A0, I_RW_A1, I_RW_A2, I_RW_G1, I_RW_G2, I_RW_KK, I_RW_KA, I_RW_RK, I_RW_LG, I_RW_LB, I_RW_O,
       I_LRU_IN, I_LRU_CW, I_LRU_CB, I_LRU_WA, I_LRU_BA, I_LRU_WX, I_LRU_BX, I_LRU_LAM, I_LRU_OUT };

namespace pg8 {
constexpr int BM = 256, BK = 64, HALF = 128, HTB = HALF * BK * 2, STAGE_BYTES = 8 * HTB, NXCD = 8, WGM = 8;
DEV int lds_byte(int r, int c) { const int st = (r >> 4) * 2 + (c >> 5), rr = r & 15, cc = c & 31, ob = rr * 64 + cc * 2; return st * 1024 + (ob ^ (((ob >> 9) & 1) << 5)); }
DEV void stage_rc(int b, int& R, int& C) { const int st = b / 1024, sb = b % 1024, swz = sb ^ (((sb >> 9) & 1) << 5); R = (st >> 1) * 16 + swz / 64; C = (st & 1) * 32 + (swz % 64) / 2; }
struct Unit { int pm, pn; };
struct Gemm { const bf16_t* A; const bf16_t* Bt; int lda, K, nM, nN, a_grp; };
struct StaticOrder {
    int nM, nN, nwg, G, c;
    DEV void init(int nM_, int nN_, int G_, int c_) { nM = nM_; nN = nN_; nwg = nM * nN; G = G_; c = c_; }
    DEV bool next(int i, Unit& u) const {
        const long L = (long)i * G + c; if (L >= nwg) return false;
        int wgid = (int)L; { const int q = nwg / NXCD, r = nwg % NXCD, xcd = wgid % NXCD, off = wgid / NXCD; wgid = (xcd < r ? xcd * (q + 1) : r * (q + 1) + (xcd - r) * q) + off; }
        const int nig = WGM * nN, gid = wgid / nig, fm = gid * WGM, gsz = (nM - fm) < WGM ? (nM - fm) : WGM;
        u.pm = fm + ((wgid % nig) % gsz); u.pn = (wgid % nig) / gsz; return true;
    }
};
template <class Epi>
DEV void gemm_phase(const int wid_s_, LAS unsigned char* lds, const Gemm g, const Epi& E) {
    StaticOrder S; S.init(g.nM, g.nN, (int)gridDim.x, obid());
    const int tid = otid(), wid = __builtin_amdgcn_readfirstlane(tid >> 6), lane = tid & 63, wr = wid >> 2, wc = wid & 3, fr = lane & 15, fq = lane >> 4;
    const int K = g.K, nt = K / BK, lda = g.lda;
    unsigned voffA[2], voffB[2];
#pragma unroll
    for (int i = 0; i < 2; ++i) { int R, C; stage_rc(tid * 16 + i * 8192, R, C); voffA[i] = (unsigned)(R * lda + C) * 2u; voffB[i] = (unsigned)(R * K + C) * 2u; }
    const size_t kstep = (size_t)(BK * 2);
    const size_t hstepA = (size_t)HALF * lda * 2, hstepB = (size_t)HALF * K * 2;
    const size_t tstepA = 2 * hstepA, tstepB = 2 * hstepB;
    const unsigned ldsw = (unsigned)wid * 1024u;
    const int aoff = lds_byte(wr * 64 + fr, fq * 8), boff = lds_byte(wc * 32 + fr, fq * 8);
#define PG8_SA(b, h) (((b) * 2 + (h)) * HTB)
#define PG8_SB(b, h) ((4 + (b) * 2 + (h)) * HTB)
#define PG8_STAGE(bufoff, gbase, voff) do { _Pragma("unroll") for (int _i = 0; _i < 2; ++_i) \
        __builtin_amdgcn_global_load_lds((const unsigned*)((const char*)(gbase) + (voff)[_i]), (LAS unsigned*)(lds + (bufoff) + ldsw + _i * 8192), 16, 0, 0); } while (0)
#define PG8_LDA(dst, b, h) do { _Pragma("unroll") for (int m = 0; m < 4; ++m) _Pragma("unroll") for (int k = 0; k < 2; ++k) dst[m][k] = *(const LAS bf16x8*)(lds + PG8_SA(b, h) + aoff + m * 2048 + k * 1024); } while (0)
#define PG8_LDB(dst, b, h) do { _Pragma("unroll") for (int n = 0; n < 2; ++n) _Pragma("unroll") for (int k = 0; k < 2; ++k) dst[n][k] = *(const LAS bf16x8*)(lds + PG8_SB(b, h) + boff + n * 2048 + k * 1024); } while (0)
#define PG8_MMA(ai, bj, At, Bt) do { __builtin_amdgcn_s_setprio(1); _Pragma("unroll") for (int m = 0; m < 4; ++m) _Pragma("unroll") for (int n = 0; n < 2; ++n) _Pragma("unroll") for (int k = 0; k < 2; ++k) \
        acc[ai][bj][m][n] = __builtin_amdgcn_mfma_f32_16x16x32_bf16(Bt[n][k], At[m][k], acc[ai][bj][m][n], 0, 0, 0); __builtin_amdgcn_s_setprio(0); } while (0)
#define PG8_WAIT_V(n) asm volatile("s_waitcnt vmcnt(" #n ")" ::: "memory")
#define PG8_WAIT_L(n) asm volatile("s_waitcnt lgkmcnt(" #n ")" ::: "memory")
#define PG8_BAR __builtin_amdgcn_s_barrier()
#define PG8_SCHED __builtin_amdgcn_sched_barrier(0)
#define PG8_UA(u) ((const char*)g.A + (size_t)(u).pm * tstepA + (g.a_grp ? (size_t)((u).pn / g.a_grp) * (size_t)K * 2 : (size_t)0))
#define PG8_UB(u) ((const char*)g.Bt + (size_t)(u).pn * tstepB)
    Unit cur, nxt; int ui = 0;
    if (!S.next(0, cur)) return;
    f32x4 acc[2][2][4][2];
#pragma unroll
    for (int a = 0; a < 2; ++a)
#pragma unroll
        for (int b = 0; b < 2; ++b)
#pragma unroll
            for (int m = 0; m < 4; ++m)
#pragma unroll
                for (int n = 0; n < 2; ++n) acc[a][b][m][n] = (f32x4){0.f, 0.f, 0.f, 0.f};
    bf16x8 At[4][2], B0[2][2], B1[2][2];
    const char* cA = PG8_UA(cur); const char* cB = PG8_UB(cur);
    PG8_STAGE(PG8_SB(0, 0), cB, voffB); PG8_STAGE(PG8_SA(0, 0), cA, voffA); PG8_STAGE(PG8_SB(0, 1), cB + hstepB, voffB); PG8_STAGE(PG8_SA(0, 1), cA + hstepA, voffA);
    if (wr == 1) PG8_BAR;
    PG8_WAIT_V(4); PG8_BAR;
    PG8_STAGE(PG8_SB(1, 0), cB + kstep, voffB); PG8_STAGE(PG8_SA(1, 0), cA + kstep, voffA); PG8_STAGE(PG8_SB(1, 1), cB + hstepB + kstep, voffB);
    PG8_WAIT_V(6); PG8_BAR;
    for (;;) {
        const bool has_next = S.next(ui + 1, nxt);
        const char* nA = has_next ? PG8_UA(nxt) : cA; const char* nB = has_next ? PG8_UB(nxt) : cB;
        for (int t = 0; t < nt; t += 2) {
            const bool last = (t == nt - 2);
            const char* a1 = cA + (size_t)(t + 1) * kstep;
            const char* a2 = last ? nA : cA + (size_t)(t + 2) * kstep; const char* b2 = last ? nB : cB + (size_t)(t + 2) * kstep;
            const char* a3 = a2 + kstep; const char* b3 = b2 + kstep;
            PG8_LDB(B0, 0, 0); PG8_SCHED; PG8_LDA(At, 0, 0); PG8_STAGE(PG8_SA(1, 1), a1 + hstepA, voffA);
            PG8_WAIT_L(8); PG8_BAR; PG8_WAIT_L(0); PG8_MMA(0, 0, At, B0); PG8_BAR; PG8_SCHED;
            PG8_LDB(B1, 0, 1); PG8_STAGE(PG8_SB(0, 0), b2, voffB);
            PG8_BAR; PG8_WAIT_L(0); PG8_MMA(0, 1, At, B1); PG8_BAR;
            PG8_LDA(At, 0, 1); PG8_STAGE(PG8_SA(0, 0), a2, voffA);
            PG8_BAR; PG8_WAIT_L(0); PG8_MMA(1, 0, At, B0); PG8_BAR; PG8_SCHED;
            PG8_STAGE(PG8_SB(0, 1), b2 + hstepB, voffB);
            PG8_WAIT_V(6); PG8_BAR; PG8_MMA(1, 1, At, B1); PG8_BAR;
            PG8_LDB(B0, 1, 0); PG8_SCHED; PG8_LDA(At, 1, 0); PG8_STAGE(PG8_SA(0, 1), a2 + hstepA, voffA);
            PG8_WAIT_L(8); PG8_BAR; PG8_WAIT_L(0); PG8_MMA(0, 0, At, B0); PG8_BAR; PG8_SCHED;
            PG8_LDB(B1, 1, 1); PG8_STAGE(PG8_SB(1, 0), b3, voffB);
            PG8_BAR; PG8_WAIT_L(0); PG8_MMA(0, 1, At, B1); PG8_BAR;
            PG8_LDA(At, 1, 1); PG8_STAGE(PG8_SA(1, 0), a3, voffA);
            PG8_BAR; PG8_WAIT_L(0); PG8_MMA(1, 0, At, B0); PG8_BAR; PG8_SCHED;
            PG8_STAGE(PG8_SB(1, 1), b3 + hstepB, voffB);
            PG8_WAIT_V(6); PG8_BAR; PG8_MMA(1, 1, At, B1); PG8_BAR;
        }
        E(acc, cur, wr, wc, fr, fq);
        if (!has_next) break;
#pragma unroll
        for (int a = 0; a < 2; ++a)
#pragma unroll
            for (int b = 0; b < 2; ++b)
#pragma unroll
                for (int m = 0; m < 4; ++m)
#pragma unroll
                    for (int n = 0; n < 2; ++n) acc[a][b][m][n] = (f32x4){0.f, 0.f, 0.f, 0.f};
        cur = nxt; cA = nA; cB = nB; ++ui;
    }
    PG8_WAIT_V(0);
    if (wr == 0) PG8_BAR;
    PG8_BAR;
#undef PG8_SA
#undef PG8_SB
#undef PG8_STAGE
#undef PG8_LDA
#undef PG8_LDB
#undef PG8_MMA
#undef PG8_UA
#undef PG8_UB
}
}
using pg8::Unit;
typedef const f32x4 (&AccRef)[2][2][4][2];
#define EPI_ROWS _Pragma("unroll") for (int ai = 0; ai < 2; ++ai) _Pragma("unroll") for (int m = 0; m < 4; ++m) if ((__builtin_amdgcn_sched_barrier(0), true))
#define EPI_ROW (u.pm * 256 + ai * 128 + wr * 64 + m * 16 + fr)
#define EPI_COLS _Pragma("unroll") for (int bj = 0; bj < 2; ++bj) _Pragma("unroll") for (int n = 0; n < 2; ++n)
#define EPI_CC (bj * 128 + wc * 32 + n * 16 + fq * 4)

struct EpiFfnUp { bf16_t* H;
    DEV void operator()(AccRef acc, const Unit& u, int wr, int wc, int fr, int fq) const {
        EPI_ROWS { const int row = EPI_ROW;
#pragma unroll
            for (int bj = 0; bj < 2; ++bj) { const int col = (u.pn * 8 + bj * 4 + wc) * 16 + fq * 4; const f32x4 a = acc[ai][bj][m][0], b = acc[ai][bj][m][1];
                uint2 o; o.x = pack2(siluf_(a[0]) * b[0], siluf_(a[1]) * b[1]); o.y = pack2(siluf_(a[2]) * b[2], siluf_(a[3]) * b[3]);
                *(uint2*)(H + (size_t)row * DFF + col) = o; } }
    } };
struct EpiResid { float* X; const float* XS; float s; const float2* st; const float* g; const float* b;
    DEV void operator()(AccRef acc, const Unit& u, int wr, int wc, int fr, int fq) const {
        const int row0 = u.pm * 256 + wr * 64 + fr;
        float mu[8], rs[8];
#pragma unroll
        for (int r = 0; r < 8; ++r) { mu[r] = 0.f; rs[r] = 1.f; if (st) { const float2 t = st[row0 + (r >> 2) * 128 + (r & 3) * 16]; mu[r] = t.x; rs[r] = t.y; } }
#pragma unroll
        for (int bj = 0; bj < 2; ++bj)
#pragma unroll
            for (int n = 0; n < 2; ++n) { __builtin_amdgcn_sched_barrier(0);
                const int col = u.pn * 256 + EPI_CC; f32x4 gv = {1.f, 1.f, 1.f, 1.f}, bv = {0.f, 0.f, 0.f, 0.f};
                if (st) { gv = *(const f32x4*)(g + col); bv = *(const f32x4*)(b + col); }
#pragma unroll
                for (int r = 0; r < 8; ++r) { const int ai = r >> 2, m = r & 3; const size_t eo = (size_t)(row0 + ai * 128 + m * 16) * DM + col; f32x4* p = (f32x4*)(X + eo); f32x4 v = *(const f32x4*)(XS + eo);
                    if (st) v = (v - mu[r]) * rs[r] * gv + bv;
                    *p = v * ALPHA + acc[ai][bj][m][n] * s; } }
    } };
struct EpiF32 { float* C; int ldc;
    DEV void operator()(AccRef acc, const Unit& u, int wr, int wc, int fr, int fq) const {
        EPI_ROWS { float* rp = C + (size_t)EPI_ROW * ldc + u.pn * 256;
            EPI_COLS { *(f32x4*)(rp + EPI_CC) = acc[ai][bj][m][n]; } }
    } };
struct EpiRetQKV { bf16_t *Q, *Kr, *Kt, *Vt; const float2* cs;
    DEV void operator()(AccRef acc, const Unit& u, int wr, int wc, int fr, int fq) const {
        const int pn = u.pn;
        if (pn < 8) {
            const int h = pn & 3; const bool isk = pn >= 4;
            const float lg2 = log2f(1.0f - exp2f(-5.0f - (float)h));
            EPI_ROWS { const int row = EPI_ROW, t = row & (TSEQ - 1), b = row >> 14;
                const float kdec = exp2f((float)(127 - (t & 127)) * lg2) * 0.0625f;
#pragma unroll
                for (int n = 0; n < 2; ++n) { const int j = wc * 32 + n * 16 + fq * 4; float o1[4], o2[4];
#pragma unroll
                    for (int i = 0; i < 4; ++i) { const float2 c = cs[(size_t)t * 128 + j + i]; const float t1 = acc[ai][0][m][n][i], t2 = acc[ai][1][m][n][i]; o1[i] = t1 * c.x - t2 * c.y; o2[i] = t1 * c.y + t2 * c.x; }
                    if (!isk) { bf16_t* p = Q + (size_t)row * 1024 + h * 256 + j; uint2 a, bb; a.x = pack2(o1[0], o1[1]); a.y = pack2(o1[2], o1[3]); bb.x = pack2(o2[0], o2[1]); bb.y = pack2(o2[2], o2[3]);
                        *(uint2*)p = a; *(uint2*)(p + 128) = bb; }
                    else { bf16_t* p = Kr + (size_t)row * 1024 + h * 256 + j; uint2 a, bb; a.x = pack2(o1[0] * 0.0625f, o1[1] * 0.0625f); a.y = pack2(o1[2] * 0.0625f, o1[3] * 0.0625f);
                        bb.x = pack2(o2[0] * 0.0625f, o2[1] * 0.0625f); bb.y = pack2(o2[2] * 0.0625f, o2[3] * 0.0625f); *(uint2*)p = a; *(uint2*)(p + 128) = bb;
                        bf16_t* pt = Kt + ((size_t)(((b * 4 + h) * 128 + (t >> 7)) * 256 + j)) * 128 + (t & 127);
#pragma unroll
                        for (int i = 0; i < 4; ++i) { pt[i * 128] = f2bf(o1[i] * kdec); pt[(i + 128) * 128] = f2bf(o2[i] * kdec); } } } }
        } else {
            const int h = (pn - 8) >> 1, eb = ((pn - 8) & 1) * 256;
            EPI_ROWS { const int row = EPI_ROW, t = row & (TSEQ - 1), b = row >> 14;
                EPI_COLS { const int e = eb + EPI_CC; bf16_t* pt = Vt + ((size_t)(((b * 4 + h) * 128 + (t >> 7)) * 512 + e)) * 128 + (t & 127);
#pragma unroll
                    for (int i = 0; i < 4; ++i) pt[i * 128] = f2bf(acc[ai][bj][m][n][i]); } }
        }
    } };
struct EpiMulBf { bf16_t* O; int ldo; int mode;
    bf16_t* O2;
    DEV void operator()(AccRef acc, const Unit& u, int wr, int wc, int fr, int fq) const {
        EPI_ROWS { const size_t ro = (size_t)EPI_ROW * ldo + u.pn * 256;
            EPI_COLS { const uint2 v = *(const uint2*)(O + ro + EPI_CC); const f32x4 a = acc[ai][bj][m][n]; float f[4] = {bf2f((bf16_t)(v.x & 0xffff)), bf2f((bf16_t)(v.x >> 16)), bf2f((bf16_t)(v.y & 0xffff)), bf2f((bf16_t)(v.y >> 16))};
                float r[4];
#pragma unroll
                for (int i = 0; i < 4; ++i) r[i] = mode == 0 ? siluf_(a[i]) * f[i] : f[i] * sigmoidf_(a[i]);
                uint2 o; o.x = pack2(r[0], r[1]); o.y = pack2(r[2], r[3]); *(uint2*)((mode == 0 ? O : O2) + ro + EPI_CC) = o; } }
    } };
struct EpiRw1 { bf16_t *R, *L;
    DEV void operator()(AccRef acc, const Unit& u, int wr, int wc, int fr, int fq) const {
        const int pn = u.pn;
        EPI_ROWS { const int row = EPI_ROW;
            EPI_COLS { const int cc = EPI_CC; f32x4 a = acc[ai][bj][m][n]; uint2 o;
                if (pn < 12) { bf16_t* dst = R + (size_t)(pn >> 2) * (UNIT / 2); o.x = pack2(a[0], a[1]); o.y = pack2(a[2], a[3]); *(uint2*)(dst + (size_t)row * 1024 + (pn & 3) * 256 + cc) = o; }
                else { float r[4];
#pragma unroll
                    for (int i = 0; i < 4; ++i) r[i] = bj == 1 ? sigmoidf_(a[i]) : (wc < 2 ? tanhf_(a[i]) : a[i]);
                    o.x = pack2(r[0], r[1]); o.y = pack2(r[2], r[3]); *(uint2*)(L + (size_t)row * 256 + cc) = o; } } }
    } };
struct EpiRw2 { bf16_t *EW; const float *w0, *a0;
    DEV void operator()(AccRef acc, const Unit& u, int wr, int wc, int fr, int fq) const {
        const int pn = u.pn;
        EPI_ROWS { const int row = EPI_ROW;
            EPI_COLS { __builtin_amdgcn_sched_barrier(0); const int c = (pn & 3) * 256 + EPI_CC; f32x4 a = acc[ai][bj][m][n]; float r[4];
                if (pn < 4) { const f32x4 w = *(const f32x4*)(w0 + c);
#pragma unroll
                    for (int i = 0; i < 4; ++i) r[i] = 0.6065306597126334f * sigmoidf_(w[i] + a[i]); }
                else if (pn < 8) { const f32x4 w = *(const f32x4*)(a0 + c);
#pragma unroll
                    for (int i = 0; i < 4; ++i) r[i] = sigmoidf_(w[i] + a[i]); }
                else {
#pragma unroll
                    for (int i = 0; i < 4; ++i) r[i] = a[i]; }
                uint2 o; o.x = pack2(r[0], r[1]); o.y = pack2(r[2], r[3]); *(uint2*)(EW + (size_t)(pn >> 2) * (UNIT / 2) + (size_t)row * 1024 + c) = o; } }
    } };
struct EpiLruIn { bf16_t *GATE, *XR;
    DEV void operator()(AccRef acc, const Unit& u, int wr, int wc, int fr, int fq) const {
        const int pn = u.pn;
        EPI_ROWS { const int row = EPI_ROW;
            EPI_COLS { const int c = (pn & 3) * 256 + EPI_CC; f32x4 a = acc[ai][bj][m][n]; uint2 o;
                if (pn < 4) { o.x = pack2(geluf_(a[0]), geluf_(a[1])); o.y = pack2(geluf_(a[2]), geluf_(a[3])); *(uint2*)(GATE + (size_t)row * 1024 + c) = o; }
                else { o.x = pack2(a[0], a[1]); o.y = pack2(a[2], a[3]); *(uint2*)(XR + (size_t)row * 1024 + c) = o; } } }
    } };
struct EpiLruAx { unsigned* PK; const bf16_t* XC; const float *ba, *bx, *lam;
    DEV void operator()(AccRef acc, const Unit& u, int wr, int wc, int fr, int fq) const {
        const int pn = u.pn;
        EPI_ROWS { const int row = EPI_ROW;
#pragma unroll
            for (int bj = 0; bj < 2; ++bj) { __builtin_amdgcn_sched_barrier(0); const int ch = (pn >> 1) * 256 + ((pn & 1) * 8 + bj * 4 + wc) * 16 + fq * 4;
                const f32x4 ga = acc[ai][bj][m][0], gx = acc[ai][bj][m][1]; const f32x4 vba = *(const f32x4*)(ba + ch), vbx = *(const f32x4*)(bx + ch), vl = *(const f32x4*)(lam + ch);
                const uint2 xv = *(const uint2*)(XC + (size_t)row * 1024 + ch); const float xf[4] = {bf2f((bf16_t)(xv.x & 0xffff)), bf2f((bf16_t)(xv.x >> 16)), bf2f((bf16_t)(xv.y & 0xffff)), bf2f((bf16_t)(xv.y >> 16))};
                unsigned ow[4];
#pragma unroll
                for (int i = 0; i < 4; ++i) { const float r = sigmoidf_(ga[i] + vba[i]), it = sigmoidf_(gx[i] + vbx[i]);
                    const float la = -8.0f * r * softplus_neg(vl[i]); ow[i] = pack2(neg_expm1(la), sqrtf(neg_expm1(2.0f * la)) * (it * xf[i])); }
                *(uint4*)(PK + (size_t)row * 1024 + ch) = make_uint4(ow[0], ow[1], ow[2], ow[3]); } }
    } };

DEV void cvt_t(const int wid_s_, float* lf, bf16_t* dst, int dld, int dn0, int dk0, const float* src, int sld, int sc0, int N, int K, const float* ks, int perm) {
    const int tn = N >> 6, tiles = tn * (K >> 6), tid = otid();
    for (int tile = obid(); tile < tiles; tile += gridDim.x) {
        const int n0 = (tile % tn) * 64, k0 = (tile / tn) * 64;
#pragma unroll
        for (int i = 0; i < 8; ++i) { const int kk = (tid >> 6) + 8 * i, nn = tid & 63; float v = src[(size_t)(k0 + kk) * sld + sc0 + n0 + nn]; if (ks) v *= ks[k0 + kk]; lf[kk * 65 + nn] = v; }
        __syncthreads();
#pragma unroll
        for (int i = 0; i < 8; ++i) { const int nn = (tid >> 6) + 8 * i, kk = tid & 63, n = n0 + nn; const int pn = perm < 0 ? n : ((n >> 4) * 32 + perm * 16 + (n & 15));
            dst[(size_t)(dn0 + pn) * dld + dk0 + k0 + kk] = f2bf(lf[kk * 65 + nn]); }
        __syncthreads();
    }
}
DEV void fill0(const int wid_s_, bf16_t* dst, int dld, int n0, int k0, int N, int K) {
    const int per = K >> 3; const long tot = (long)N * per;
    for (long i = (long)obid() * blockDim.x + otid(); i < tot; i += (long)gridDim.x * blockDim.x) { const int n = (int)(i / per), k = (int)(i % per) * 8; *(uint4*)(dst + (size_t)(n0 + n) * dld + k0 + k) = make_uint4(0, 0, 0, 0); }
}
constexpr size_t W_UP0 = 0, W_DN0 = 5767168, W_UP1 = 8650752, W_DN1 = 14417920, W_MIX = 17301504;
DEV void convert_layer(const int wid_s_, CP p, int layer, float* lf) {
    bf16_t* W = (bf16_t*)p->ws;
    for (int s = 0; s < 2; ++s) { const size_t wo = (size_t)(layer * 2 + s) * 1024 * DFF;
        cvt_t(wid_s_, lf, W + (s ? W_UP1 : W_UP0), 1024, 0, 0, p->in[I_W1] + wo, DFF, 0, DFF, 1024, nullptr, 0);
        cvt_t(wid_s_, lf, W + (s ? W_UP1 : W_UP0), 1024, 0, 0, p->in[I_W3] + wo, DFF, 0, DFF, 1024, nullptr, 1);
        cvt_t(wid_s_, lf, W + (s ? W_DN1 : W_DN0), DFF, 0, 0, p->in[I_W2] + wo, 1024, 0, 1024, DFF, nullptr, -1); }
    bf16_t* X = W + W_MIX;
    if (layer == 0) { cvt_t(wid_s_, lf, X, 1024, 0, 0, p->in[I_RET_IN], 6144, 0, 6144, 1024, nullptr, -1); cvt_t(wid_s_, lf, X + 6291456, 2048, 0, 0, p->in[I_RET_OUT], 1024, 0, 1024, 2048, nullptr, -1); }
    else if (layer == 1) { cvt_t(wid_s_, lf, X, 1024, 0, 0, p->in[I_S5_IN], 1024, 0, 1024, 1024, nullptr, -1); cvt_t(wid_s_, lf, X + 1048576, 1024, 0, 0, p->in[I_S5_GLU], 1024, 0, 1024, 1024, nullptr, -1);
        cvt_t(wid_s_, lf, X + 2097152, 1024, 0, 0, p->in[I_S5_OUT], 1024, 0, 1024, 1024, nullptr, -1); }
    else if (layer == 2) { const float* mu = p->in[I_RW_MU];
        const float* srcs[6] = {p->in[I_RW_R], p->in[I_RW_K], p->in[I_RW_V], p->in[I_RW_W1], p->in[I_RW_A1], p->in[I_RW_G1]};
        const int mus[6] = {0, 2, 3, 1, 4, 5}, n0s[6] = {0, 1024, 2048, 3072, 3136, 3200}, ns[6] = {1024, 1024, 1024, 64, 64, 128};
#pragma unroll
        for (int q = 0; q < 6; ++q) { cvt_t(wid_s_, lf, X, 2048, n0s[q], 0, srcs[q], ns[q], 0, ns[q], 1024, nullptr, -1); cvt_t(wid_s_, lf, X + 0, 2048, n0s[q], 1024, srcs[q], ns[q], 0, ns[q], 1024, mu + mus[q] * 1024, -1); }
        bf16_t* X2 = X + 6815744;
        cvt_t(wid_s_, lf, X2, 256, 0, 0, p->in[I_RW_W2], 1024, 0, 1024, 64, nullptr, -1); cvt_t(wid_s_, lf, X2, 256, 1024, 64, p->in[I_RW_A2], 1024, 0, 1024, 64, nullptr, -1); cvt_t(wid_s_, lf, X2, 256, 2048, 128, p->in[I_RW_G2], 1024, 0, 1024, 128, nullptr, -1);
        fill0(wid_s_, X2, 256, 0, 64, 1024, 192); fill0(wid_s_, X2, 256, 1024, 0, 1024, 64); fill0(wid_s_, X2, 256, 1024, 128, 1024, 128); fill0(wid_s_, X2, 256, 2048, 0, 1024, 128);
        cvt_t(wid_s_, lf, X + 7602176, 1024, 0, 0, p->in[I_RW_O], 1024, 0, 1024, 1024, nullptr, -1); }
    else { cvt_t(wid_s_, lf, X, 1024, 0, 0, p->in[I_LRU_IN], 2048, 0, 2048, 1024, nullptr, -1);
        for (int blk = 0; blk < 4; ++blk) { cvt_t(wid_s_, lf, X + 2097152, 256, blk * 512, 0, p->in[I_LRU_WA] + blk * 65536, 256, 0, 256, 256, nullptr, 0); cvt_t(wid_s_, lf, X + 2097152, 256, blk * 512, 0, p->in[I_LRU_WX] + blk * 65536, 256, 0, 256, 256, nullptr, 1); }
        cvt_t(wid_s_, lf, X + 2621440, 1024, 0, 0, p->in[I_LRU_OUT], 1024, 0, 1024, 1024, nullptr, -1); }
}

DEV void ln_phase(const int wid_s_, float* X, bf16_t* XB, const float* g, const float* b, float2* st, const bool write_x) {
    const int lane = otid() & 63, wv = otid() >> 6;
    f32x4 gv[4], bv[4];
#pragma unroll
    for (int j = 0; j < 4; ++j) { gv[j] = *(const f32x4*)(g + j * 256 + lane * 4); bv[j] = *(const f32x4*)(b + j * 256 + lane * 4); }
    for (int row = obid() * 8 + wv; row < M_TOK; row += gridDim.x * 8) {
        float* rp = X + (size_t)row * DM; f32x4 v[4]; float s = 0.f;
#pragma unroll
        for (int j = 0; j < 4; ++j) { v[j] = __builtin_nontemporal_load((const f32x4*)(rp + j * 256 + lane * 4)); s += v[j][0] + v[j][1] + v[j][2] + v[j][3]; }
        const float mu = wave_sum_fast(s) * (1.0f / DM); float q = 0.f;
#pragma unroll
        for (int j = 0; j < 4; ++j) { v[j] = v[j] - mu; q += v[j][0] * v[j][0] + v[j][1] * v[j][1] + v[j][2] * v[j][2] + v[j][3] * v[j][3]; }
        const float rs = rsqrtf(wave_sum_fast(q) * (1.0f / DM) + 1e-5f);
        if (lane == 0) st[row] = make_float2(mu, rs);
#pragma unroll
        for (int j = 0; j < 4; ++j) { f32x4 o = v[j] * rs * gv[j] + bv[j]; if (write_x) *(f32x4*)(rp + j * 256 + lane * 4) = o;
            uint2 pk; pk.x = pack2(o[0], o[1]); pk.y = pack2(o[2], o[3]); *(uint2*)(XB + (size_t)row * DM + j * 256 + lane * 4) = pk; }
    }
}

DEV void ln_prep_phase(const int wid_s_, const float* X, bf16_t* A2, const float* g, const float* b, float2* st) {
    const int lane = otid() & 63, wv = otid() >> 6;
    f32x4 gv[4], bv[4];
#pragma unroll
    for (int j = 0; j < 4; ++j) { gv[j] = *(const f32x4*)(g + j * 256 + lane * 4); bv[j] = *(const f32x4*)(b + j * 256 + lane * 4); }
    for (int r0 = (obid() * 8 + wv) * 16; r0 < M_TOK; r0 += gridDim.x * 8 * 16) {
        f32x4 prev[4], cur[4], nxt[4];
        const bool has_prev = (r0 & (TSEQ - 1)) != 0; const int first = has_prev ? r0 - 1 : r0;
#pragma unroll
        for (int j = 0; j < 4; ++j) { nxt[j] = *(const f32x4*)(X + (size_t)first * DM + j * 256 + lane * 4); prev[j] = (f32x4){0.f, 0.f, 0.f, 0.f}; }
        for (int row = first; row < r0 + 16; ++row) {
#pragma unroll
            for (int j = 0; j < 4; ++j) cur[j] = nxt[j];
            if (row + 1 < r0 + 16) {
#pragma unroll
                for (int j = 0; j < 4; ++j) nxt[j] = *(const f32x4*)(X + (size_t)(row + 1) * DM + j * 256 + lane * 4); }
            float s = 0.f;
#pragma unroll
            for (int j = 0; j < 4; ++j) s += cur[j][0] + cur[j][1] + cur[j][2] + cur[j][3];
            const float mu = wave_sum_fast(s) * (1.0f / DM); float q = 0.f;
#pragma unroll
            for (int j = 0; j < 4; ++j) { cur[j] = cur[j] - mu; q += cur[j][0] * cur[j][0] + cur[j][1] * cur[j][1] + cur[j][2] * cur[j][2] + cur[j][3] * cur[j][3]; }
            const float rs = rsqrtf(wave_sum_fast(q) * (1.0f / DM) + 1e-5f);
#pragma unroll
            for (int j = 0; j < 4; ++j) cur[j] = cur[j] * rs * gv[j] + bv[j];
            if (row >= r0) {
                if (lane == 0) st[row] = make_float2(mu, rs);
#pragma unroll
                for (int j = 0; j < 4; ++j) { uint2 o; o.x = pack2(cur[j][0], cur[j][1]); o.y = pack2(cur[j][2], cur[j][3]); *(uint2*)(A2 + (size_t)row * 2048 + j * 256 + lane * 4) = o;
                    const f32x4 d = prev[j] - cur[j]; o.x = pack2(d[0], d[1]); o.y = pack2(d[2], d[3]); *(uint2*)(A2 + (size_t)row * 2048 + 1024 + j * 256 + lane * 4) = o; } }
#pragma unroll
            for (int j = 0; j < 4; ++j) prev[j] = cur[j];
        }
    }
}

DEV void ret_s_phase(const int wid_s_, const bf16_t* Q, const bf16_t* Kr, bf16_t* Sb) {
    const int lane = otid() & 63, w = otid() >> 6, fr = lane & 15, fq = lane >> 4;
    for (int item = obid(); item < 1024; item += gridDim.x) {
        const int h = item & 3, c = (item >> 2) & 127, b = item >> 9; const size_t rowbase = (size_t)b * TSEQ + c * 128;
        const float lg2 = log2f(1.0f - exp2f(-5.0f - (float)h));
        bf16x8 yq[8];
#pragma unroll
        for (int ks = 0; ks < 8; ++ks) yq[ks] = *(const bf16x8*)(Q + (rowbase + 16 * w + fr) * 1024 + h * 256 + ks * 32 + fq * 8);
        bf16_t* So = Sb + (size_t)item * 16384;
        const int ii = 16 * w + fr;
        for (int jt = 0; jt <= w; ++jt) {
            f32x4 acc = {0.f, 0.f, 0.f, 0.f};
#pragma unroll
            for (int ks = 0; ks < 8; ++ks) { const bf16x8 xk = *(const bf16x8*)(Kr + (rowbase + 16 * jt + fr) * 1024 + h * 256 + ks * 32 + fq * 8); acc = __builtin_amdgcn_mfma_f32_16x16x32_bf16(xk, yq[ks], acc, 0, 0, 0); }
            float r[4];
#pragma unroll
            for (int i = 0; i < 4; ++i) { const int jj = 16 * jt + fq * 4 + i; r[i] = (ii >= jj) ? acc[i] * exp2f((float)(ii - jj) * lg2) : 0.f; }
            uint2 o; o.x = pack2(r[0], r[1]); o.y = pack2(r[2], r[3]); *(uint2*)(So + ii * 128 + 16 * jt + fq * 4) = o;
        }
        if (!(w & 1)) *(uint2*)(So + ii * 128 + 16 * (w + 1) + fq * 4) = make_uint2(0, 0);
    }
}
template <int MODE> DEV void ret_scan_phase(const int wid_s_, LAS unsigned char* lds, const bf16_t* Q, const bf16_t* Kt, bf16_t* Vt, const bf16_t* Sb, float* Eseg) {
    const int bid = obid(); if (bid >= 256) return;
    const int lane = otid() & 63, w = otid() >> 6, fr = lane & 15, fq = lane >> 4;
    const int grp = (bid & 7) * 4 + (bid >> 6), et = (bid >> 3) & 7, seg = grp & 3, bh = grp >> 2, b = bh >> 2, h = bh & 3, item = bh * 8 + et, e0 = et * 64;
    if (MODE == 0 && seg == 3) return;
    LAS bf16_t* Rt = (LAS bf16_t*)lds;
    const float lg2 = log2f(1.0f - exp2f(-5.0f - (float)h)); const float cd = exp2f(128.0f * lg2);
    f32x4 racc[4][2];
#pragma unroll
    for (int a = 0; a < 4; ++a) { racc[a][0] = (f32x4){0.f, 0.f, 0.f, 0.f}; racc[a][1] = (f32x4){0.f, 0.f, 0.f, 0.f}; }
    bf16_t* Vh0 = Vt + ((size_t)((b * 4 + h) * 128) * 512 + e0) * 128;
    const bf16_t* Kh0 = Kt + ((size_t)((b * 4 + h) * 128) * 256) * 128;
    bf16x8 vt[4][4], yk[2][4];
    if (MODE == 0) {
        for (int c = seg * 32; c < seg * 32 + 32; ++c) { const bf16_t* Vc = Vh0 + (size_t)c * 512 * 128; const bf16_t* Kc = Kh0 + (size_t)c * 256 * 128;
#pragma unroll
            for (int a = 0; a < 4; ++a)
#pragma unroll
                for (int ks = 0; ks < 4; ++ks) vt[a][ks] = *(const bf16x8*)(Vc + (a * 16 + fr) * 128 + ks * 32 + fq * 8);
#pragma unroll
            for (int dt = 0; dt < 2; ++dt)
#pragma unroll
                for (int ks = 0; ks < 4; ++ks) yk[dt][ks] = *(const bf16x8*)(Kc + (32 * w + 16 * dt + fr) * 128 + ks * 32 + fq * 8);
#pragma unroll
            for (int a = 0; a < 4; ++a) { racc[a][0] *= cd; racc[a][1] *= cd; }
#pragma unroll
            for (int dt = 0; dt < 2; ++dt)
#pragma unroll
                for (int ks = 0; ks < 4; ++ks) {
#pragma unroll
                    for (int a = 0; a < 4; ++a) racc[a][dt] = __builtin_amdgcn_mfma_f32_16x16x32_bf16(vt[a][ks], yk[dt][ks], racc[a][dt], 0, 0, 0); } }
        float* Eo = Eseg + (size_t)(item * 3 + seg) * 16384;
#pragma unroll
        for (int a = 0; a < 4; ++a)
#pragma unroll
            for (int dt = 0; dt < 2; ++dt)
#pragma unroll
                for (int i = 0; i < 4; ++i) Eo[(a * 16 + fq * 4 + i) * 256 + 32 * w + 16 * dt + fr] = racc[a][dt][i];
        return;
    }
    {
        const float cd32 = exp2f(32.0f * 128.0f * lg2); float wgt = 1.0f;
        for (int sp = seg - 1; sp >= 0; --sp) { const float* Ei = Eseg + (size_t)(item * 3 + sp) * 16384;
#pragma unroll
            for (int a = 0; a < 4; ++a)
#pragma unroll
                for (int dt = 0; dt < 2; ++dt)
#pragma unroll
                    for (int i = 0; i < 4; ++i) racc[a][dt][i] += wgt * Ei[(a * 16 + fq * 4 + i) * 256 + 32 * w + 16 * dt + fr];
            wgt *= cd32; }
#pragma unroll
        for (int a = 0; a < 4; ++a)
#pragma unroll
            for (int dt = 0; dt < 2; ++dt)
#pragma unroll
                for (int i = 0; i < 4; ++i) Rt[(a * 16 + fq * 4 + i) * 264 + 32 * w + 16 * dt + fr] = f2bf(racc[a][dt][i]);
    }
    __syncthreads();
    float qd[4];
#pragma unroll
    for (int i = 0; i < 4; ++i) qd[i] = exp2f((float)(16 * w + fq * 4 + i + 1) * lg2);
    const int nks = (16 * w + 15) / 32 + 1;
    bf16x8 xq[8], xs[4];
#define RS_LOAD(c_) do { const int cc_ = (c_); const bf16_t* Vc = Vh0 + (size_t)cc_ * 512 * 128; const bf16_t* Kc = Kh0 + (size_t)cc_ * 256 * 128; const size_t rb = (size_t)b * TSEQ + cc_ * 128; \
        const bf16_t* Sc = Sb + ((size_t)((b * 128 + cc_) * 4 + h)) * 16384; \
        _Pragma("unroll") for (int ks = 0; ks < 8; ++ks) xq[ks] = *(const bf16x8*)(Q + (rb + 16 * w + fr) * 1024 + h * 256 + ks * 32 + fq * 8); \
        _Pragma("unroll") for (int a = 0; a < 4; ++a) _Pragma("unroll") for (int ks = 0; ks < 4; ++ks) vt[a][ks] = *(const bf16x8*)(Vc + (a * 16 + fr) * 128 + ks * 32 + fq * 8); \
        _Pragma("unroll") for (int ks = 0; ks < 4; ++ks) if (ks < nks) xs[ks] = *(const bf16x8*)(Sc + (16 * w + fr) * 128 + ks * 32 + fq * 8); \
        _Pragma("unroll") for (int dt = 0; dt < 2; ++dt) _Pragma("unroll") for (int ks = 0; ks < 4; ++ks) yk[dt][ks] = *(const bf16x8*)(Kc + (32 * w + 16 * dt + fr) * 128 + ks * 32 + fq * 8); } while (0)
    const int c_end = seg * 32 + 32;
    RS_LOAD(seg * 32);
    for (int c = seg * 32; c < c_end; ++c) {
        bf16_t* Vh = Vh0 + (size_t)c * 512 * 128;
        f32x4 oacc[4];
#pragma unroll
        for (int a = 0; a < 4; ++a) oacc[a] = (f32x4){0.f, 0.f, 0.f, 0.f};
#pragma unroll
        for (int ks = 0; ks < 8; ++ks) {
#pragma unroll
            for (int a = 0; a < 4; ++a) { const bf16x8 yr = *(const LAS bf16x8*)(Rt + (a * 16 + fr) * 264 + ks * 32 + fq * 8); oacc[a] = __builtin_amdgcn_mfma_f32_16x16x32_bf16(xq[ks], yr, oacc[a], 0, 0, 0); } }
#pragma unroll
        for (int a = 0; a < 4; ++a)
#pragma unroll
            for (int i = 0; i < 4; ++i) oacc[a][i] *= qd[i];
#pragma unroll
        for (int ks = 0; ks < 4; ++ks) if (ks < nks) {
#pragma unroll
            for (int a = 0; a < 4; ++a) oacc[a] = __builtin_amdgcn_mfma_f32_16x16x32_bf16(xs[ks], vt[a][ks], oacc[a], 0, 0, 0); }
#pragma unroll
        for (int a = 0; a < 4; ++a) { racc[a][0] *= cd; racc[a][1] *= cd; }
#pragma unroll
        for (int dt = 0; dt < 2; ++dt)
#pragma unroll
            for (int ks = 0; ks < 4; ++ks) {
#pragma unroll
                for (int a = 0; a < 4; ++a) racc[a][dt] = __builtin_amdgcn_mfma_f32_16x16x32_bf16(vt[a][ks], yk[dt][ks], racc[a][dt], 0, 0, 0); }
        __syncthreads();
        if (c + 1 < c_end) RS_LOAD(c + 1);
#pragma unroll
        for (int a = 0; a < 4; ++a) { uint2 o; o.x = pack2(oacc[a][0], oacc[a][1]); o.y = pack2(oacc[a][2], oacc[a][3]); *(uint2*)(Vh + (a * 16 + fr) * 128 + 16 * w + fq * 4) = o;
#pragma unroll
            for (int dt = 0; dt < 2; ++dt)
#pragma unroll
                for (int i = 0; i < 4; ++i) Rt[(a * 16 + fq * 4 + i) * 264 + 32 * w + 16 * dt + fr] = f2bf(racc[a][dt][i]); }
        __syncthreads();
    }
#undef RS_LOAD
}
DEV void ret_norm_phase(const int wid_s_, LAS unsigned char* lds, const bf16_t* Ot, bf16_t* ON) {
    LAS bf16_t* T = (LAS bf16_t*)lds;
    const int lane = otid() & 63, w = otid() >> 6, tid = otid();
    for (int item = obid(); item < 2048; item += gridDim.x) {
        const int tt = item & 255, h = (item >> 8) & 3, b = item >> 10; const int t0 = tt * 64;
        { const bf16_t* src = Ot + ((size_t)(((b * 4 + h) * 128 + (tt >> 1)) * 512 + tid)) * 128 + (tt & 1) * 64;
#pragma unroll
            for (int q = 0; q < 8; ++q) { const uint4 v = *(const uint4*)(src + q * 8); LAS unsigned* d = (LAS unsigned*)(T + tid * 66 + q * 8); d[0] = v.x; d[1] = v.y; d[2] = v.z; d[3] = v.w; } }
        __syncthreads();
        for (int k = 0; k < 8; ++k) { const int tk = w * 8 + k; float v[8]; float s = 0.f;
#pragma unroll
            for (int q = 0; q < 8; ++q) { v[q] = bf2f(T[(lane + 64 * q) * 66 + tk]); s += v[q]; }
            const float mu = wave_sum(s) * (1.0f / 512.0f); float qq = 0.f;
#pragma unroll
            for (int q = 0; q < 8; ++q) { v[q] -= mu; qq += v[q] * v[q]; }
            const float rs = rsqrtf(wave_sum(qq) * (1.0f / 512.0f) + 1e-5f);
            bf16_t* dst = ON + ((size_t)b * TSEQ + t0 + tk) * 2048 + h * 512;
#pragma unroll
            for (int q = 0; q < 8; ++q) dst[lane + 64 * q] = f2bf(v[q] * rs); }
        __syncthreads();
    }
}

struct S5Coef { float are, aim; float bre[16], bim[16]; };
constexpr size_t S5TAB_OFF = 56ull << 20;
DEV void s5_build_table(const int wid_s_, CP p, float* tab) {
    for (int gn = obid() * 512 + otid(); gn < 4096; gn += gridDim.x * 512) { const int g = gn >> 6;
        const double dt = exp((double)p->in[I_S5_LS][g]); const double ar = p->in[I_S5_ARE][gn], ai = p->in[I_S5_AIM][gn];
        const double mag = exp(dt * ar); double sn, cs; sincos(dt * ai, &sn, &cs);
        const double abr = mag * cs, abi = mag * sn, den = ar * ar + ai * ai;
        const double fre = ((abr - 1.0) * ar + abi * ai) / den, fim = (abi * ar - (abr - 1.0) * ai) / den;
        float* t = tab + (size_t)gn * 36; t[0] = (float)abr; t[1] = (float)abi;
        const double mL = exp(64.0 * dt * ar); double s2, c2; sincos(64.0 * dt * ai, &s2, &c2); t[2] = (float)(mL * c2); t[3] = (float)(mL * s2);
        for (int q = 0; q < 16; ++q) { const double br = p->in[I_S5_BRE][gn * 16 + q], bi = p->in[I_S5_BIM][gn * 16 + q]; t[4 + q] = (float)(fre * br - fim * bi); t[20 + q] = (float)(fre * bi + fim * br); } }
}
DEV void s5_coef(CP p, int g, int n, S5Coef& c, float* aLre, float* aLim) {
    const float* t = (const float*)(p->ws + S5TAB_OFF) + (size_t)(g * 64 + n) * 36;
    const f32x4 h = *(const f32x4*)t; c.are = h[0]; c.aim = h[1]; if (aLre) { *aLre = h[2]; *aLim = h[3]; }
#pragma unroll
    for (int q4 = 0; q4 < 4; ++q4) { const f32x4 a = *(const f32x4*)(t + 4 + q4 * 4), b = *(const f32x4*)(t + 20 + q4 * 4);
#pragma unroll
        for (int i = 0; i < 4; ++i) { c.bre[q4 * 4 + i] = a[i]; c.bim[q4 * 4 + i] = b[i]; } }
}
template <bool OUT> DEV void s5_scan_phase(const int wid_s_, CP p, LAS unsigned char* lds, const float* U, float2* E, bf16_t* ACT) {
    const int lane = otid() & 63, w = wid_s_, fr = lane & 15, fq = lane >> 4; const int g = (obid() & 7) * 8 + w;
    S5Coef cf; s5_coef(p, g, lane, cf, nullptr, nullptr);
    typedef float f32x2s __attribute__((ext_vector_type(2)));
    f32x2s cb[16];
#pragma unroll
    for (int q = 0; q < 16; ++q) cb[q] = (f32x2s){cf.bre[q], cf.bim[q]};
    LAS bf16_t* hb = (LAS bf16_t*)lds + w * (16 * 136);
    bf16x8 cfrag[4]; float dsk = 0.f;
    if (OUT) { dsk = p->in[I_S5_D][g * 16 + fr];
#pragma unroll
        for (int ks = 0; ks < 4; ++ks) { const bool im = ks >= 2; const float* src = (im ? p->in[I_S5_CIM] : p->in[I_S5_CRE]) + (g * 16 + fr) * 64 + (ks & 1) * 32 + fq * 8;
#pragma unroll
            for (int i = 0; i < 8; ++i) cfrag[ks][i] = (short)f2bf(im ? -src[i] : src[i]); } }
    for (int item = obid(); item < 4096; item += gridDim.x) {
        const int ch = (item >> 3) & 255, b = item >> 11; const size_t row0 = (size_t)b * TSEQ + ch * 64;
        float hre = 0.f, him = 0.f; const size_t eidx = ((size_t)(b * 256 + ch) * 64 + g) * 64 + lane;
        if (OUT) { const float2 h0 = E[eidx]; hre = h0.x; him = h0.y; }
        for (int t16 = 0; t16 < 64; t16 += 16) {
#pragma unroll 4
            for (int tt = 0; tt < 16; ++tt) { const float* up = U + (row0 + t16 + tt) * 1024 + g * 16; f32x2s bu = {0.f, 0.f};
#pragma unroll
                for (int q4 = 0; q4 < 4; ++q4) { const f32x4 uv = *(const f32x4*)(up + q4 * 4);
#pragma unroll
                    for (int i = 0; i < 4; ++i) bu += cb[q4 * 4 + i] * uv[i]; }
                const float nr = cf.are * hre - cf.aim * him + bu[0], ni = cf.are * him + cf.aim * hre + bu[1]; hre = nr; him = ni;
                if (OUT) { hb[tt * 136 + lane] = f2bf(hre); hb[tt * 136 + 64 + lane] = f2bf(him); } }
            if (OUT) { f32x4 acc = {0.f, 0.f, 0.f, 0.f};
#pragma unroll
                for (int ks = 0; ks < 4; ++ks) { const bf16x8 hf = *(const LAS bf16x8*)(hb + fr * 136 + ks * 32 + fq * 8); acc = __builtin_amdgcn_mfma_f32_16x16x32_bf16(hf, cfrag[ks], acc, 0, 0, 0); }
#pragma unroll
                for (int i = 0; i < 4; ++i) { const size_t o = (row0 + t16 + fq * 4 + i) * 1024 + g * 16 + fr; ACT[o] = f2bf(geluf_(acc[i] + dsk * U[o])); } }
        }
        if (!OUT) E[eidx] = make_float2(hre, him);
    }
}
DEV void s5_carry_phase(const int wid_s_, CP p, float2* E) {
    const int gid = obid() * 512 + otid(); if (gid >= 8192) return;
    const int b = gid >> 12, gn = gid & 4095; S5Coef cf; float are, aim; s5_coef(p, gn >> 6, gn & 63, cf, &are, &aim);
    float hre = 0.f, him = 0.f; float2* e = E + (size_t)b * 256 * 4096 + gn;
    for (int c0 = 0; c0 < 256; c0 += 8) { float2 v[8];
#pragma unroll
        for (int k = 0; k < 8; ++k) v[k] = e[(size_t)(c0 + k) * 4096];
#pragma unroll
        for (int k = 0; k < 8; ++k) { e[(size_t)(c0 + k) * 4096] = make_float2(hre, him); const float nr = are * hre - aim * him + v[k].x, ni = are * him + aim * hre + v[k].y; hre = nr; him = ni; } }
}

DEV void rw_prep_phase(const int wid_s_, const float* X, bf16_t* A2, const float2* st, const float* g, const float* b) {
    for (long i = (long)obid() * 512 + otid(); i < (long)M_TOK * 256; i += (long)gridDim.x * 512) {
        const int row = (int)(i >> 8), c = (int)(i & 255) * 4; const f32x4 gv = *(const f32x4*)(g + c), bv = *(const f32x4*)(b + c);
        const float2 t = st[row]; const f32x4 v = (*(const f32x4*)(X + (size_t)row * 1024 + c) - t.x) * t.y * gv + bv;
        f32x4 pv = {0.f, 0.f, 0.f, 0.f}; if (row & (TSEQ - 1)) { const float2 tp = st[row - 1]; pv = (*(const f32x4*)(X + (size_t)(row - 1) * 1024 + c) - tp.x) * tp.y * gv + bv; }
        uint2 o; o.x = pack2(v[0], v[1]); o.y = pack2(v[2], v[3]); *(uint2*)(A2 + (size_t)row * 2048 + c) = o;
        const f32x4 d = pv - v; o.x = pack2(d[0], d[1]); o.y = pack2(d[2], d[3]); *(uint2*)(A2 + (size_t)row * 2048 + 1024 + c) = o;
    }
}
DEV void rw_scan_phase(const int wid_s_, CP p, LAS unsigned char* lds, const bf16_t* R, const bf16_t* Kk, const bf16_t* V, const bf16_t* EW, const bf16_t* AA, bf16_t* Y) {
    const int bid = obid(); if (bid >= 256) return;
    const int bh = (bid & 7) * 4 + (bid >> 6), rg = (bid >> 3) & 7, b = bh >> 4, h = bh & 15;
    const int tid = otid();
    constexpr int TC = 32, BUF = 5 * TC * 64 + TC * 8, NCH = TSEQ / TC;
    LAS float* L0 = (LAS float*)lds; LAS float* YB = L0 + 2 * BUF;
    const bool isprod = (wid_s_ & 2) != 0; const int pw = (wid_s_ >> 2) * 2 + (wid_s_ & 1), pl = tid & 63, pt = pw * 64 + pl, phalf = pl >> 5, pc2 = (pl & 31) * 2;
    float kkw0 = 0.f, kkw1 = 0.f, kaw0 = 0.f, kaw1 = 0.f;
    if (isprod) { kkw0 = p->in[I_RW_KK][h * 64 + pc2]; kkw1 = p->in[I_RW_KK][h * 64 + pc2 + 1]; kaw0 = p->in[I_RW_KA][h * 64 + pc2]; kaw1 = p->in[I_RW_KA][h * 64 + pc2 + 1]; }
    unsigned pk[4], pa[4], pew[4], pr[4], pv[4];
    auto pload = [&](int c) {
#pragma unroll
        for (int i = 0; i < 4; ++i) { const int tok = pw * 8 + i * 2 + phalf; const size_t g = ((size_t)b * TSEQ + c * TC + tok) * 1024 + h * 64 + pc2;
            pk[i] = *(const unsigned*)(Kk + g); pa[i] = *(const unsigned*)(AA + g); pew[i] = *(const unsigned*)(EW + g); pr[i] = *(const unsigned*)(R + g);
            pv[i] = pc2 < 8 ? *(const unsigned*)(V + g - pc2 + rg * 8 + pc2) : 0u; }
    };
    typedef float f32x2p __attribute__((ext_vector_type(2)));
    auto pstage = [&](int buf) { LAS float* B = L0 + buf * BUF;
#pragma unroll
        for (int i = 0; i < 4; ++i) { const int tok = pw * 8 + i * 2 + phalf;
            const float k0 = __uint_as_float(pk[i] << 16), k1 = __uint_as_float(pk[i] & 0xffff0000u), a0 = __uint_as_float(pa[i] << 16), a1 = __uint_as_float(pa[i] & 0xffff0000u);
            const float e0 = __uint_as_float(pew[i] << 16), e1 = __uint_as_float(pew[i] & 0xffff0000u);
            const float kv0 = k0 * kkw0, kv1 = k1 * kkw1; const float s16 = sum16(kv0 * kv0 + kv1 * kv1);
            const float t0 = rdlane(s16, 0) + rdlane(s16, 16), t1 = rdlane(s16, 32) + rdlane(s16, 48);
            const float rn = __builtin_amdgcn_rsqf(fmaxf(phalf ? t1 : t0, 1e-24f)); const float kk0 = kv0 * rn, kk1 = kv1 * rn;
            LAS float* q = B + tok * 64 + pc2;
            *(LAS f32x2p*)(q + 0 * TC * 64) = (f32x2p){__expf(-e0), __expf(-e1)}; *(LAS f32x2p*)(q + 1 * TC * 64) = (f32x2p){kk0, kk1}; *(LAS f32x2p*)(q + 2 * TC * 64) = (f32x2p){kk0 * a0, kk1 * a1};
            *(LAS f32x2p*)(q + 3 * TC * 64) = (f32x2p){k0 * (1.0f + (a0 - 1.0f) * kaw0), k1 * (1.0f + (a1 - 1.0f) * kaw1)};
            *(LAS f32x2p*)(q + 4 * TC * 64) = (f32x2p){__uint_as_float(pr[i] << 16), __uint_as_float(pr[i] & 0xffff0000u)};
            if (pc2 < 8) *(LAS f32x2p*)(B + 5 * TC * 64 + tok * 8 + pc2) = (f32x2p){__uint_as_float(pv[i] << 16), __uint_as_float(pv[i] & 0xffff0000u)}; }
    };
    auto store_y = [&](int c) { Y[((size_t)b * TSEQ + c * TC + (pt >> 3)) * 1024 + h * 64 + rg * 8 + (pt & 7)] = f2bf(YB[(c & 1) * TC * 8 + pt]); };
    if (isprod) { pload(0); pstage(0); pload(1); }
    __syncthreads();
    typedef float f32x2 __attribute__((ext_vector_type(2)));
    f32x2 Sa = {0.f, 0.f}, Sb2 = {0.f, 0.f}; const int rowi = tid >> 4, c4 = (tid & 15) * 4, l16 = tid & 15;
    const bool sel8 = (l16 & 8) != 0, sel4 = (l16 & 4) != 0, sel2 = (l16 & 2) != 0, sel1 = (l16 & 1) != 0;
    for (int c = 0; c < NCH; ++c) {
        const int buf = c & 1;
        if (isprod) { if (c + 1 < NCH) pstage(buf ^ 1); if (c + 2 < NCH) pload(c + 2); if (c > 0) store_y(c - 1); }
        else if (tid < 128) { LAS float* B = L0 + buf * BUF; LAS float* yb = YB + buf * TC * 8;
            f32x4 w[4], kk[4], bb[4], km[4], rr[4]; float v[4];
#define RW_LOAD(slot, tk) do { w[slot] = *(const LAS f32x4*)(B + 0 * TC * 64 + (tk) * 64 + c4); kk[slot] = *(const LAS f32x4*)(B + 1 * TC * 64 + (tk) * 64 + c4); bb[slot] = *(const LAS f32x4*)(B + 2 * TC * 64 + (tk) * 64 + c4); \
                km[slot] = *(const LAS f32x4*)(B + 3 * TC * 64 + (tk) * 64 + c4); rr[slot] = *(const LAS f32x4*)(B + 4 * TC * 64 + (tk) * 64 + c4); v[slot] = B[5 * TC * 64 + (tk) * 8 + rowi]; } while (0)
#define RW_STEP(slot, j) do { \
                const f32x2 kA = {kk[slot][0], kk[slot][1]}, kB = {kk[slot][2], kk[slot][3]}; const f32x2 wA = {w[slot][0], w[slot][1]}, wB = {w[slot][2], w[slot][3]}; \
                const f32x2 mA = {km[slot][0], km[slot][1]}, mB = {km[slot][2], km[slot][3]}; const f32x2 bA = {bb[slot][0], bb[slot][1]}, bB = {bb[slot][2], bb[slot][3]}; \
                const f32x2 rA = {rr[slot][0], rr[slot][1]}, rB = {rr[slot][2], rr[slot][3]}; \
                const f32x2 pd = Sa * kA + Sb2 * kB; const float sa = -sum16(pd[0] + pd[1]); \
                const f32x2 TA = Sa * wA + mA * v[slot], TB = Sb2 * wB + mB * v[slot]; \
                Sa = TA + bA * sa; Sb2 = TB + bB * sa; \
                const f32x2 py = Sa * rA + Sb2 * rB; yp[j] = py[0] + py[1]; } while (0)
#pragma unroll 1
            for (int t16 = 0; t16 < TC; t16 += 16) {
                float yp[16];
                RW_LOAD(0, t16); RW_LOAD(1, t16 + 1); RW_LOAD(2, t16 + 2);
#pragma unroll
                for (int j = 0; j < 16; j += 4) {
                    if (j + 3 < 16) RW_LOAD(3, t16 + j + 3);
                    RW_STEP(0, j);
                    if (j + 4 < 16) RW_LOAD(0, t16 + j + 4);
                    RW_STEP(1, j + 1);
                    if (j + 5 < 16) RW_LOAD(1, t16 + j + 5);
                    RW_STEP(2, j + 2);
                    if (j + 6 < 16) RW_LOAD(2, t16 + j + 6);
                    RW_STEP(3, j + 3);
                }
                float y8[8], y4[4], y2[2];
#pragma unroll
                for (int q = 0; q < 8; ++q) { const float keep = sel8 ? yp[q + 8] : yp[q], send = sel8 ? yp[q] : yp[q + 8]; y8[q] = keep + dppf<0x140>(send); }
#pragma unroll
                for (int q = 0; q < 4; ++q) { const float keep = sel4 ? y8[q + 4] : y8[q], send = sel4 ? y8[q] : y8[q + 4]; y4[q] = keep + dppf<0x141>(send); }
#pragma unroll
                for (int q = 0; q < 2; ++q) { const float keep = sel2 ? y4[q + 2] : y4[q], send = sel2 ? y4[q] : y4[q + 2]; y2[q] = keep + dppf<0x4E>(send); }
                { const float keep = sel1 ? y2[1] : y2[0], send = sel1 ? y2[0] : y2[1]; yb[(t16 + l16) * 8 + rowi] = keep + dppf<0xB1>(send); }
            }
#undef RW_LOAD
#undef RW_STEP
        }
        __syncthreads();
    }
    if (isprod) store_y(NCH - 1);
}
DEV void rw_post_phase(const int wid_s_, CP p, const bf16_t* Y, bf16_t* R, const bf16_t* Kk, const bf16_t* V, const bf16_t* AA, const bf16_t* G) {
    const int lane = otid() & 63, w = otid() >> 6;
    for (long it = (long)obid() * 8 + w; it < (long)M_TOK * 4; it += (long)gridDim.x * 8) {
        const int hq = (int)(it & 3); const size_t g0 = (size_t)(it >> 2) * 1024 + hq * 256 + lane; const int ch0 = hq * 256 + lane;
        float y[4], r[4], k[4], v[4], a[4], gg[4];
#pragma unroll
        for (int q = 0; q < 4; ++q) { const size_t g = g0 + q * 64; y[q] = bf2f(Y[g]); r[q] = bf2f(R[g]); k[q] = bf2f(Kk[g]); v[q] = bf2f(V[g]); a[q] = bf2f(AA[g]); gg[q] = bf2f(G[g]); }
#pragma unroll
        for (int q = 0; q < 4; ++q) { const int ch = ch0 + q * 64;
            const float mu = wave_sum_fast(y[q]) * (1.0f / 64.0f); const float d = y[q] - mu; const float var = wave_sum_fast(d * d) * (1.0f / 64.0f);
            const float yn = d * rsqrtf(var + 64e-5f) * p->in[I_RW_LG][ch] + p->in[I_RW_LB][ch];
            const float km = k[q] * (1.0f + (a[q] - 1.0f) * p->in[I_RW_KA][ch]); const float bonus = wave_sum_fast(r[q] * km * p->in[I_RW_RK][ch]);
            R[g0 + q * 64] = f2bf((yn + bonus * v[q]) * gg[q]); }
    }
}

DEV void lru_conv_phase(const int wid_s_, CP p, const bf16_t* XR, bf16_t* XC) {
    const float* cw = p->in[I_LRU_CW]; const float* cb = p->in[I_LRU_CB];
    for (long i = (long)obid() * 512 + otid(); i < (long)M_TOK * 128; i += (long)gridDim.x * 512) {
        const int row = (int)(i >> 7), c = (int)(i & 127) * 8, t = row & (TSEQ - 1); float acc[8];
#pragma unroll
        for (int q = 0; q < 8; ++q) acc[q] = cb[c + q];
#pragma unroll
        for (int j = 0; j < 4; ++j) { if (t - 3 + j < 0) continue; const uint4 v = *(const uint4*)(XR + (size_t)(row - 3 + j) * 1024 + c); const unsigned u[4] = {v.x, v.y, v.z, v.w};
#pragma unroll
            for (int q = 0; q < 4; ++q) { acc[2 * q] += cw[j * 1024 + c + 2 * q] * bf2f((bf16_t)(u[q] & 0xffff)); acc[2 * q + 1] += cw[j * 1024 + c + 2 * q + 1] * bf2f((bf16_t)(u[q] >> 16)); } }
        uint4 o; o.x = pack2(acc[0], acc[1]); o.y = pack2(acc[2], acc[3]); o.z = pack2(acc[4], acc[5]); o.w = pack2(acc[6], acc[7]); *(uint4*)(XC + (size_t)row * 1024 + c) = o;
    }
}
template <bool OUT> DEV void lru_scan_phase(const int wid_s_, const unsigned* PK, float2* CP, bf16_t* GATE) {
    for (int item = obid(); item < 1024; item += gridDim.x) {
        const int half = item & 1, chk = (item >> 1) & 255, b = item >> 9; const int ch = half * 512 + otid(); const size_t row0 = (size_t)b * TSEQ + chk * 64;
        const size_t ci = (size_t)(b * 256 + chk) * 1024 + ch;
        float h = 0.f, P = 1.f; if (OUT) h = CP[ci].x;
#pragma unroll 8
        for (int t = 0; t < 64; ++t) { const size_t g = (row0 + t) * 1024 + ch; const unsigned pw = PK[g]; const float a = 1.0f - __uint_as_float(pw << 16), x = __uint_as_float(pw & 0xffff0000u); h = a * h + x; P *= a;
            if (OUT) GATE[g] = f2bf(h * bf2f(GATE[g])); }
        if (!OUT) CP[ci] = make_float2(P, h);
    }
}
DEV void lru_carry_phase(const int wid_s_, float2* CP) {
    const int gid = obid() * 512 + otid(); if (gid >= 2048) return;
    const int b = gid >> 10, ch = gid & 1023; float2* e = CP + (size_t)b * 256 * 1024 + ch; float h = 0.f;
    for (int c0 = 0; c0 < 256; c0 += 8) { float2 v[8];
#pragma unroll
        for (int k = 0; k < 8; ++k) v[k] = e[(size_t)(c0 + k) * 1024];
#pragma unroll
        for (int k = 0; k < 8; ++k) { e[(size_t)(c0 + k) * 1024].x = h; h = v[k].x * h + v[k].y; } }
}

constexpr size_t BAR_OFF = 58ull << 20;
#define XB_TMO      128
#define XB_XCNT(j)  (256  + 64 * (j))
#define XB_XSUB(j)  (1280 + 64 * (j))
#define XB_XGEN(j)  (2304 + 64 * (j))
#define XB_TOP      3328
#define XB_TOPGEN   3392
#define XB_SPIN_CAP (1u << 18)
DEV unsigned xb_ld(unsigned* p) { return __hip_atomic_load(p, __ATOMIC_RELAXED, __HIP_MEMORY_SCOPE_AGENT); }
DEV unsigned xb_add(unsigned* p, unsigned v) { return __hip_atomic_fetch_add(p, v, __ATOMIC_RELAXED, __HIP_MEMORY_SCOPE_AGENT); }
DEV unsigned xb_xcc_id() { return (unsigned)__builtin_amdgcn_s_getreg((3 << 11) | 20) & 0xFu; }
#define XB_SPIN(cond, bar) do { unsigned _sp = 0; while (cond) { __builtin_amdgcn_s_sleep(1); \
    if ((++_sp & 255u) == 0u) { if (xb_ld(&(bar)[XB_TMO])) break; if (_sp > XB_SPIN_CAP) { atomicAdd(&(bar)[XB_TMO], 1u); break; } } } } while (0)
DEV void xcd_complete(unsigned* bar, unsigned x, unsigned& nloc, unsigned& nx) {
    const unsigned G = gridDim.x; unsigned sum, cnt, mine, sp = 0u;
    for (;;) { sum = 0u; cnt = 0u; mine = 0u;
#pragma unroll
        for (unsigned j = 0; j < 16; ++j) { const unsigned c = xb_ld(&bar[XB_XCNT(j)]); sum += c; cnt += (c > 0u) ? 1u : 0u; mine = (j == x) ? c : mine; }
        if (sum == G) break;
        __builtin_amdgcn_s_sleep(1);
        if ((++sp & 255u) == 0u) { if (xb_ld(&bar[XB_TMO])) break; if (sp > XB_SPIN_CAP) { atomicAdd(&bar[XB_TMO], 1u); break; } } }
    nloc = mine > 0u ? mine : 1u; nx = cnt > 0u ? cnt : 1u;
}
DEV void grid_barrier(const int wid_s_, unsigned* bar, volatile LAS unsigned* st) {
    asm volatile("s_waitcnt vmcnt(0)" ::: "memory");
    __syncthreads();
    if (otid() == 0) {
        __builtin_amdgcn_s_waitcnt(0);
        const unsigned x = xb_xcc_id();
        unsigned nloc = st[0], nx = st[1];
        if (nloc == 0u) { xcd_complete(bar, x, nloc, nx); st[0] = nloc; st[1] = nx; }
        const unsigned old = xb_add(&bar[XB_XSUB(x)], 1u);
        const unsigned gen = old / nloc;
        if (old + 1u == (gen + 1u) * nloc) {
            __builtin_amdgcn_fence(__ATOMIC_RELEASE, "agent");
            asm volatile("s_waitcnt vmcnt(0)" ::: "memory");
            const unsigned og = xb_add(&bar[XB_TOP], 1u);
            const unsigned tg = og / nx;
            if (og + 1u == (tg + 1u) * nx) xb_add(&bar[XB_TOPGEN], 1u);
            else XB_SPIN(xb_ld(&bar[XB_TOPGEN]) == tg, bar);
            __builtin_amdgcn_fence(__ATOMIC_ACQUIRE, "agent");
            xb_add(&bar[XB_XGEN(x)], 1u);
            asm volatile("s_waitcnt vmcnt(0)" ::: "memory");
        } else {
            XB_SPIN(xb_ld(&bar[XB_XGEN(x)]) == gen, bar);
            __builtin_amdgcn_fence(__ATOMIC_ACQUIRE, "agent");
            asm volatile("s_waitcnt vmcnt(0)" ::: "memory");
        }
    }
    __syncthreads();
}
template <class T> DEV T* olaunder(T* q) { asm volatile("" : "+s"(q)); return q; }
#define PTRS CP p = (CP)__builtin_amdgcn_kernarg_segment_ptr(); asm volatile("" : "+s"(p)); unsigned char* ws = olaunder(p->ws); float* X = olaunder(p->x); bf16_t* W = (bf16_t*)ws; bf16_t* XB = (bf16_t*)(ws + UNIT); unsigned char* AR = ws + 2 * UNIT; bf16_t* WX = W + W_MIX; \
    (void)X; (void)W; (void)XB; (void)AR; (void)WX;
#define GEMM(A_, lda_, Bt_, K_, N_, agrp_, E_) do { pg8::Gemm g; g.A = (A_); g.Bt = (Bt_); g.lda = (lda_); g.K = (K_); g.nM = M_TOK / 256; g.nN = (N_) / 256; g.a_grp = (agrp_); pg8::gemm_phase(wid_s_, lds, g, E_); } while (0)
#define STATS ((float2*)(ws + (59ull << 20)))
#define LNG_(L) (p->in[I_LNG] + (L) * 1024)
#define LNB_(L) (p->in[I_LNB] + (L) * 1024)
#define CS_ ((float2*)(AR + 5 * UNIT + UNIT / 2))
#define RQ ((bf16_t*)AR)
#define RKr ((bf16_t*)(AR + UNIT))
#define RKt ((bf16_t*)(AR + 2 * UNIT))
#define RVt ((bf16_t*)(AR + 3 * UNIT))
#define RSb ((bf16_t*)(AR + 5 * UNIT))
#define RES ((float*)(AR + 5 * UNIT + 3 * (UNIT / 4)))
#define SU ((float*)AR)
#define SACT ((bf16_t*)(AR + 2 * UNIT))
#define SZ ((bf16_t*)(AR + 3 * UNIT))
#define SE5 ((float2*)(AR + 4 * UNIT))
#define WA2 ((bf16_t*)AR)
#define WR ((bf16_t*)(AR + 3 * UNIT))
#define WK ((bf16_t*)(AR + 4 * UNIT))
#define WV ((bf16_t*)(AR + 5 * UNIT))
#define WG ((bf16_t*)(AR + 2 * UNIT))
#define WL XB
#define WY XB
#define WEW ((bf16_t*)AR)
#define WAA ((bf16_t*)(AR + UNIT))
#define LGATE ((bf16_t*)AR)
#define LXC ((bf16_t*)(AR + UNIT))
#define LAT ((float*)(AR + 2 * UNIT))
#define LINP ((float*)(AR + 4 * UNIT))
#define LXR ((bf16_t*)(AR + 4 * UNIT))
#define LCP ((float2*)(ws + (60ull << 20)))
#define PHASE(...) do { if (ph >= lo && ph < hi) { PTRS __VA_ARGS__; if (ph + 1 < hi) { if (ph == 0) grid.sync(); else grid_barrier(wid_s_, (unsigned*)(ws + BAR_OFF), (volatile LAS unsigned*)(lds + 131072)); } } ++ph; } while (0)
#define FFN_PHASES(s) \
    PHASE({ EpiFfnUp E{(bf16_t*)AR}; GEMM(XB, 1024, W + ((s) ? W_UP1 : W_UP0), 1024, 2 * DFF, 0, E); }); \
    PHASE({ constexpr int PL = layer * 3 + (s) * 2 - 1; EpiResid E{X, PL >= 0 ? X : p->in[I_X], 0.5f, PL >= 0 ? STATS : nullptr, LNG_(PL >= 0 ? PL : 0), LNB_(PL >= 0 ? PL : 0)}; GEMM((bf16_t*)AR, DFF, W + ((s) ? W_DN1 : W_DN0), DFF, 1024, 0, E); }); \
    PHASE({ if constexpr (layer == 2 && (s) == 0) ln_prep_phase(wid_s_, X, WA2, LNG_(6), LNB_(6), STATS); \
            else ln_phase(wid_s_, X, XB, LNG_(layer * 3 + (s) * 2), LNB_(layer * 3 + (s) * 2), STATS, layer * 3 + (s) * 2 == 11); \
            if ((s) == 1 && layer < 3) convert_layer(wid_s_, p, layer + 1, (float*)shm); });
#define SEQ_RET \
        PHASE({ EpiRetQKV E{RQ, RKr, RKt, RVt, CS_}; GEMM(XB, 1024, WX, 1024, 4096, 0, E); }); \
        PHASE({ ret_scan_phase<0>(wid_s_, lds, RQ, RKt, RVt, RSb, RES); ret_s_phase(wid_s_, RQ, RKr, RSb); }); \
        PHASE({ ret_scan_phase<1>(wid_s_, lds, RQ, RKt, RVt, RSb, RES); }); \
        PHASE({ ret_norm_phase(wid_s_, lds, RVt, RQ); }); \
        PHASE({ EpiMulBf E{RQ, 2048, 0, nullptr}; GEMM(XB, 1024, WX + (size_t)4096 * 1024, 1024, 2048, 0, E); });
#define SEQ_S5 \
        PHASE({ EpiF32 E{SU, 1024}; GEMM(XB, 1024, WX, 1024, 1024, 0, E); }); \
        PHASE({ s5_scan_phase<false>(wid_s_, p, lds, SU, SE5, SACT); }); \
        PHASE({ s5_carry_phase(wid_s_, p, SE5); }); \
        PHASE({ s5_scan_phase<true>(wid_s_, p, lds, SU, SE5, SACT); }); \
        PHASE({ EpiMulBf E{SACT, 1024, 1, SZ}; GEMM(SACT, 1024, WX + 1048576, 1024, 1024, 0, E); });
#define SEQ_RW \
        PHASE({ EpiRw1 E{WR, WL}; GEMM(WA2, 2048, WX, 2048, 3328, 0, E); }); \
        PHASE({ EpiRw2 E{WEW, p->in[I_RW_W0], p->in[I_RW_A0]}; GEMM(WL, 256, WX + 6815744, 256, 3072, 0, E); }); \
        PHASE({ rw_scan_phase(wid_s_, p, lds, WR, WK, WV, WEW, WAA, WY); }); \
        PHASE({ rw_post_phase(wid_s_, p, WY, WR, WK, WV, WAA, WG); });
#define SEQ_LRU \
        PHASE({ EpiLruIn E{LGATE, LXR}; GEMM(XB, 1024, WX, 1024, 2048, 0, E); }); \
        PHASE({ lru_conv_phase(wid_s_, p, LXR, LXC); }); \
        PHASE({ EpiLruAx E{(unsigned*)LAT, LXC, p->in[I_LRU_BA], p->in[I_LRU_BX], p->in[I_LRU_LAM]}; GEMM(LXC, 1024, WX + 2097152, 256, 2048, 2, E); }); \
        PHASE({ lru_scan_phase<false>(wid_s_, (const unsigned*)LAT, LCP, LGATE); }); \
        PHASE({ lru_carry_phase(wid_s_, LCP); }); \
        PHASE({ lru_scan_phase<true>(wid_s_, (const unsigned*)LAT, LCP, LGATE); });
#ifndef DUPL
#define DUPL 0
#endif
template <int layer> DEV void run_layer(const int wid_s_, LAS unsigned char* lds, unsigned char* shm, cg::grid_group& grid, int& ph, const int lo, const int hi) {
    FFN_PHASES(0)
    if constexpr (layer == 0) {
        SEQ_RET
        if constexpr ((DUPL & 1) != 0) { SEQ_RET }
        PHASE({ EpiResid E{X, X, 1.0f, STATS, LNG_(layer * 3), LNB_(layer * 3)}; GEMM(RQ, 2048, WX + 6291456, 2048, 1024, 0, E); });
    } else if constexpr (layer == 1) {
        SEQ_S5
        if constexpr ((DUPL & 2) != 0) { SEQ_S5 }
        PHASE({ EpiResid E{X, X, 1.0f, STATS, LNG_(layer * 3), LNB_(layer * 3)}; GEMM(SZ, 1024, WX + 2097152, 1024, 1024, 0, E); });
    } else if constexpr (layer == 2) {
        SEQ_RW
        if constexpr ((DUPL & 4) != 0) { SEQ_RW }
        PHASE({ EpiResid E{X, X, 1.0f, STATS, LNG_(layer * 3), LNB_(layer * 3)}; GEMM(WR, 1024, WX + 7602176, 1024, 1024, 0, E); });
    } else {
        SEQ_LRU
        if constexpr ((DUPL & 8) != 0) { SEQ_LRU }
        PHASE({ EpiResid E{X, X, 1.0f, STATS, LNG_(layer * 3), LNB_(layer * 3)}; GEMM(LGATE, 1024, WX + 2621440, 1024, 1024, 0, E); });
    }
    PHASE({ ln_phase(wid_s_, X, XB, LNG_(layer * 3 + 1), LNB_(layer * 3 + 1), STATS, false); });
    FFN_PHASES(1)
}
__global__ void __launch_bounds__(512) fwd_megakernel(Params p0) {
    extern __shared__ __attribute__((aligned(16))) unsigned char shm[];
    LAS unsigned char* lds = (LAS unsigned char*)shm;
    cg::grid_group grid = cg::this_grid();
    const int wid_s_ = __builtin_amdgcn_readfirstlane((int)(threadIdx.x >> 6));
    int ph = 0; const int lo = p0.ph_lo, hi = p0.ph_hi;
    if (threadIdx.x < 4) ((LAS unsigned*)(lds + 131072))[threadIdx.x] = 0u;
    if (threadIdx.x == 0) (void)xb_add(&((unsigned*)(p0.ws + BAR_OFF))[XB_XCNT(xb_xcc_id())], 1u);
    __syncthreads();
    PHASE({
        const float* xin = p->in[I_X];
        for (long i = (long)obid() * 512 + otid(); i < (long)M_TOK * 256; i += (long)gridDim.x * 512) { const f32x4 v = *(const f32x4*)(xin + i * 4);
            uint2 o; o.x = pack2(v[0], v[1]); o.y = pack2(v[2], v[3]); *(uint2*)(XB + i * 4) = o; }
        for (long i = (long)obid() * 512 + otid(); i < (long)TSEQ * 128; i += (long)gridDim.x * 512) { const int t = (int)(i >> 7), j = (int)(i & 127);
            const double inv = exp2(-(double)j / 128.0 * 13.287712379549449); double sn, cs; sincos((double)t * inv, &sn, &cs); CS_[i] = make_float2((float)cs, (float)sn); }
        s5_build_table(wid_s_, p, (float*)(ws + S5TAB_OFF));
        convert_layer(wid_s_, p, 0, (float*)shm);
    });
    run_layer<0>(wid_s_, lds, shm, grid, ph, lo, hi);
    run_layer<1>(wid_s_, lds, shm, grid, ph, lo, hi);
    run_layer<2>(wid_s_, lds, shm, grid, ph, lo, hi);
    run_layer<3>(wid_s_, lds, shm, grid, ph, lo, hi);
}

constexpr int N_PHASES = 1 + 4 * 6 + 6 + 6 + 6 + 7 + 4;
constexpr int LDS_BYTES = 131072 + 16;

extern "C" void kernel_launch(void* const* d_in, const int* in_sizes, int n_in, void* d_out, int out_size, void* d_ws, size_t ws_size, hipStream_t stream) {
    static int grid = 0;
    if (grid == 0) {
        int dev = 0, cus = 0, per_cu = 0;
        hipGetDevice(&dev); hipDeviceGetAttribute(&cus, hipDeviceAttributeMultiprocessorCount, dev);
        hipFuncSetAttribute((const void*)fwd_megakernel, hipFuncAttributeMaxDynamicSharedMemorySize, LDS_BYTES);
        hipOccupancyMaxActiveBlocksPerMultiprocessor(&per_cu, (const void*)fwd_megakernel, 512, LDS_BYTES);
        if (per_cu < 1) per_cu = 1;
        grid = cus * 1;
        if (n_in != 46 || ws_size < 8 * UNIT) fprintf(stderr, "kernel_launch: unexpected n_in %d / ws_size %zu\n", n_in, ws_size);
    }
    Params p{};
    for (int i = 0; i < 46; ++i) p.in[i] = (const float*)d_in[i];
    p.x = (float*)d_out; p.ws = (unsigned char*)d_ws; p.ph_lo = 0; p.ph_hi = 1000;
    hipMemsetAsync((char*)d_ws + BAR_OFF, 0, 16384, stream);
    void* args[] = {&p};
    hipError_t e = hipLaunchCooperativeKernel((const void*)fwd_megakernel, dim3(grid), dim3(512), args, LDS_BYTES, stream);
    if (e != hipSuccess) fprintf(stderr, "cooperative launch failed: %s (grid %d)\n", hipGetErrorString(e), grid);
}
```

```cpp
#include <hip/hip_runtime.h>
#include <hip/hip_cooperative_groups.h>
#include <cstdio>
namespace cg = cooperative_groups;

#define DEV __device__ __forceinline__
#define LAS __attribute__((address_space(3)))
typedef unsigned short bf16_t;
typedef short bf16x8 __attribute__((ext_vector_type(8)));
typedef float f32x4 __attribute__((ext_vector_type(4)));

constexpr int M_TOK = 32768, DM = 1024, DFF = 2816, TSEQ = 16384;
constexpr float ALPHA = 1.681792830507429f;
constexpr size_t UNIT = 64ull << 20;

DEV float bf2f(bf16_t b) { return __uint_as_float(((unsigned)b) << 16); }
DEV unsigned pack2(float a, float b) { unsigned r; asm("v_cvt_pk_bf16_f32 %0, %1, %2" : "=v"(r) : "v"(a), "v"(b)); return r; }
DEV bf16_t f2bf(float f) { return (bf16_t)pack2(f, f); }
DEV float sigmoidf_(float x) { return __builtin_amdgcn_rcpf(1.0f + __expf(-x)); }
DEV float siluf_(float x) { return x * __builtin_amdgcn_rcpf(1.0f + __expf(-x)); }
DEV float tanhf_(float x) { float e = __expf(-2.0f * fabsf(x)); float t = (1.0f - e) * __builtin_amdgcn_rcpf(1.0f + e); return x < 0.f ? -t : t; }
DEV float geluf_(float x) { return 0.5f * x * (1.0f + tanhf_(0.7978845608028654f * (x + 0.044715f * x * x * x))); }
DEV float softplus_neg(float l) { const float x = __expf(-l); return x < 0.03f ? x * (1.0f - x * (0.5f - x * (0.33333333f - 0.25f * x))) : (l < -15.f ? -l : __logf(1.0f + x)); }
DEV float neg_expm1(float y) { return y > -0.05f ? -y * (1.0f + y * (0.5f + y * (0.16666667f + y * 0.041666667f))) : 1.0f - __expf(y); }
DEV float wave_sum(float v) { for (int o = 32; o > 0; o >>= 1) v += __shfl_xor(v, o, 64); return v; }
template <int CTRL> DEV float dppf(float v) { return __int_as_float(__builtin_amdgcn_update_dpp(0, __float_as_int(v), CTRL, 0xF, 0xF, true)); }
DEV int otid_(int wv) { int t = wv * 64 + (int)__builtin_amdgcn_mbcnt_hi(~0u, __builtin_amdgcn_mbcnt_lo(~0u, 0u)); asm volatile("" : "+v"(t)); return t; }
#define otid() otid_(wid_s_)
DEV int obid() { int t = blockIdx.x; asm volatile("" : "+s"(t)); return t; }
DEV float sum16(float v) { v += dppf<0xB1>(v); v += dppf<0x4E>(v); v += dppf<0x141>(v); v += dppf<0x140>(v); return v; }
DEV float rdlane(float v, int l) { return __int_as_float(__builtin_amdgcn_readlane(__float_as_int(v), l)); }
DEV float wave_sum_fast(float v) { v = sum16(v); return (rdlane(v, 0) + rdlane(v, 16)) + (rdlane(v, 32) + rdlane(v, 48)); }

struct Params {
    const float* in[46];
    float* x;
    unsigned char* ws;
    int ph_lo, ph_hi;
};
typedef const __attribute__((address_space(4))) Params* CP;
enum { I_X, I_LNG, I_LNB, I_W1, I_W3, I_W2, I_RET_IN, I_RET_OUT, I_S5_IN, I_S5_ARE, I_S5_AIM, I_S5_BRE, I_S5_BIM, I_S5_CRE, I_S5_CIM, I_S5_D, I_S5_LS, I_S5_GLU, I_S5_OUT,
       I_RW_MU, I_RW_R, I_RW_K, I_RW_V, I_RW_W0, I_RW_W1, I_RW_W2, I_RW_A0, I_RW_A1, I_RW_A2, I_RW_G1, I_RW_G2, I_RW_KK, I_RW_KA, I_RW_RK, I_RW_LG, I_RW_LB, I_RW_O,
       I_LRU_IN, I_LRU_CW, I_LRU_CB, I_LRU_WA, I_LRU_BA, I_LRU_WX, I_LRU_BX, I_LRU_LAM, I_LRU_OUT };

namespace pg8 {
constexpr int BM = 256, BK = 64, HALF = 128, HTB = HALF * BK * 2, STAGE_BYTES = 8 * HTB, NXCD = 8, WGM = 8;
DEV int lds_byte(int r, int c) { const int st = (r >> 4) * 2 + (c >> 5), rr = r & 15, cc = c & 31, ob = rr * 64 + cc * 2; return st * 1024 + (ob ^ (((ob >> 9) & 1) << 5)); }
DEV void stage_rc(int b, int& R, int& C) { const int st = b / 1024, sb = b % 1024, swz = sb ^ (((sb >> 9) & 1) << 5); R = (st >> 1) * 16 + swz / 64; C = (st & 1) * 32 + (swz % 64) / 2; }
struct Unit { int pm, pn; };
struct Gemm { const bf16_t* A; const bf16_t* Bt; int lda, K, nM, nN, a_grp; };
struct StaticOrder {
    int nM, nN, nwg, G, c;
    DEV void init(int nM_, int nN_, int G_, int c_) { nM = nM_; nN = nN_; nwg = nM * nN; G = G_; c = c_; }
    DEV bool next(int i, Unit& u) const {
        const long L = (long)i * G + c; if (L >= nwg) return false;
        int wgid = (int)L; { const int q = nwg / NXCD, r = nwg % NXCD, xcd = wgid % NXCD, off = wgid / NXCD; wgid = (xcd < r ? xcd * (q + 1) : r * (q + 1) + (xcd - r) * q) + off; }
        const int nig = WGM * nN, gid = wgid / nig, fm = gid * WGM, gsz = (nM - fm) < WGM ? (nM - fm) : WGM;
        u.pm = fm + ((wgid % nig) % gsz); u.pn = (wgid % nig) / gsz; return true;
    }
};
template <class Epi>
DEV void gemm_phase(const int wid_s_, LAS unsigned char* lds, const Gemm g, const Epi& E) {
    StaticOrder S; S.init(g.nM, g.nN, (int)gridDim.x, obid());
    const int tid = otid(), wid = __builtin_amdgcn_readfirstlane(tid >> 6), lane = tid & 63, wr = wid >> 2, wc = wid & 3, fr = lane & 15, fq = lane >> 4;
    const int K = g.K, nt = K / BK, lda = g.lda;
    unsigned voffA[2], voffB[2];
#pragma unroll
    for (int i = 0; i < 2; ++i) { int R, C; stage_rc(tid * 16 + i * 8192, R, C); voffA[i] = (unsigned)(R * lda + C) * 2u; voffB[i] = (unsigned)(R * K + C) * 2u; }
    const size_t kstep = (size_t)(BK * 2);
    const size_t hstepA = (size_t)HALF * lda * 2, hstepB = (size_t)HALF * K * 2;
    const size_t tstepA = 2 * hstepA, tstepB = 2 * hstepB;
    const unsigned ldsw = (unsigned)wid * 1024u;
    const int aoff = lds_byte(wr * 64 + fr, fq * 8), boff = lds_byte(wc * 32 + fr, fq * 8);
#define PG8_SA(b, h) (((b) * 2 + (h)) * HTB)
#define PG8_SB(b, h) ((4 + (b) * 2 + (h)) * HTB)
#define PG8_STAGE(bufoff, gbase, voff) do { _Pragma("unroll") for (int _i = 0; _i < 2; ++_i) \
        __builtin_amdgcn_global_load_lds((const unsigned*)((const char*)(gbase) + (voff)[_i]), (LAS unsigned*)(lds + (bufoff) + ldsw + _i * 8192), 16, 0, 0); } while (0)
#define PG8_LDA(dst, b, h) do { _Pragma("unroll") for (int m = 0; m < 4; ++m) _Pragma("unroll") for (int k = 0; k < 2; ++k) dst[m][k] = *(const LAS bf16x8*)(lds + PG8_SA(b, h) + aoff + m * 2048 + k * 1024); } while (0)
#define PG8_LDB(dst, b, h) do { _Pragma("unroll") for (int n = 0; n < 2; ++n) _Pragma("unroll") for (int k = 0; k < 2; ++k) dst[n][k] = *(const LAS bf16x8*)(lds + PG8_SB(b, h) + boff + n * 2048 + k * 1024); } while (0)
#define PG8_MMA(ai, bj, At, Bt) do { __builtin_amdgcn_s_setprio(1); _Pragma("unroll") for (int m = 0; m < 4; ++m) _Pragma("unroll") for (int n = 0; n < 2; ++n) _Pragma("unroll") for (int k = 0; k < 2; ++k) \
        acc[ai][bj][m][n] = __builtin_amdgcn_mfma_f32_16x16x32_bf16(Bt[n][k], At[m][k], acc[ai][bj][m][n], 0, 0, 0); __builtin_amdgcn_s_setprio(0); } while (0)
#define PG8_WAIT_V(n) asm volatile("s_waitcnt vmcnt(" #n ")" ::: "memory")
#define PG8_WAIT_L(n) asm volatile("s_waitcnt lgkmcnt(" #n ")" ::: "memory")
#define PG8_BAR __builtin_amdgcn_s_barrier()
#define PG8_SCHED __builtin_amdgcn_sched_barrier(0)
#define PG8_UA(u) ((const char*)g.A + (size_t)(u).pm * tstepA + (g.a_grp ? (size_t)((u).pn / g.a_grp) * (size_t)K * 2 : (size_t)0))
#define PG8_UB(u) ((const char*)g.Bt + (size_t)(u).pn * tstepB)
    Unit cur, nxt; int ui = 0;
    if (!S.next(0, cur)) return;
    f32x4 acc[2][2][4][2];
#pragma unroll
    for (int a = 0; a < 2; ++a)
#pragma unroll
        for (int b = 0; b < 2; ++b)
#pragma unroll
            for (int m = 0; m < 4; ++m)
#pragma unroll
                for (int n = 0; n < 2; ++n) acc[a][b][m][n] = (f32x4){0.f, 0.f, 0.f, 0.f};
    bf16x8 At[4][2], B0[2][2], B1[2][2];
    const char* cA = PG8_UA(cur); const char* cB = PG8_UB(cur);
    PG8_STAGE(PG8_SB(0, 0), cB, voffB); PG8_STAGE(PG8_SA(0, 0), cA, voffA); PG8_STAGE(PG8_SB(0, 1), cB + hstepB, voffB); PG8_STAGE(PG8_SA(0, 1), cA + hstepA, voffA);
    if (wr == 1) PG8_BAR;
    PG8_WAIT_V(4); PG8_BAR;
    PG8_STAGE(PG8_SB(1, 0), cB + kstep, voffB); PG8_STAGE(PG8_SA(1, 0), cA + kstep, voffA); PG8_STAGE(PG8_SB(1, 1), cB + hstepB + kstep, voffB);
    PG8_WAIT_V(6); PG8_BAR;
    for (;;) {
        const bool has_next = S.next(ui + 1, nxt);
        const char* nA = has_next ? PG8_UA(nxt) : cA; const char* nB = has_next ? PG8_UB(nxt) : cB;
        for (int t = 0; t < nt; t += 2) {
            const bool last = (t == nt - 2);
            const char* a1 = cA + (size_t)(t + 1) * kstep;
            const char* a2 = last ? nA : cA + (size_t)(t + 2) * kstep; const char* b2 = last ? nB : cB + (size_t)(t + 2) * kstep;
            const char* a3 = a2 + kstep; const char* b3 = b2 + kstep;
            PG8_LDB(B0, 0, 0); PG8_SCHED; PG8_LDA(At, 0, 0); PG8_STAGE(PG8_SA(1, 1), a1 + hstepA, voffA);
            PG8_WAIT_L(8); PG8_BAR; PG8_WAIT_L(0); PG8_MMA(0, 0, At, B0); PG8_BAR; PG8_SCHED;
            PG8_LDB(B1, 0, 1); PG8_STAGE(PG8_SB(0, 0), b2, voffB);
            PG8_BAR; PG8_WAIT_L(0); PG8_MMA(0, 1, At, B1); PG8_BAR;
            PG8_LDA(At, 0, 1); PG8_STAGE(PG8_SA(0, 0), a2, voffA);
            PG8_BAR; PG8_WAIT_L(0); PG8_MMA(1, 0, At, B0); PG8_BAR; PG8_SCHED;
            PG8_STAGE(PG8_SB(0, 1), b2 + hstepB, voffB);
            PG8_WAIT_V(6); PG8_BAR; PG8_MMA(1, 1, At, B1); PG8_BAR;
            PG8_LDB(B0, 1, 0); PG8_SCHED; PG8_LDA(At, 1, 0); PG8_STAGE(PG8_SA(0, 1), a2 + hstepA, voffA);
            PG8_WAIT_L(8); PG8_BAR; PG8_WAIT_L(0); PG8_MMA(0, 0, At, B0); PG8_BAR; PG8_SCHED;
            PG8_LDB(B1, 1, 1); PG8_STAGE(PG8_SB(1, 0), b3, voffB);
            PG8_BAR; PG8_WAIT_L(0); PG8_MMA(0, 1, At, B1); PG8_BAR;
            PG8_LDA(At, 1, 1); PG8_STAGE(PG8_SA(1, 0), a3, voffA);
            PG8_BAR; PG8_WAIT_L(0); PG8_MMA(1, 0, At, B0); PG8_BAR; PG8_SCHED;
            PG8_STAGE(PG8_SB(1, 1), b3 + hstepB, voffB);
            PG8_WAIT_V(6); PG8_BAR; PG8_MMA(1, 1, At, B1); PG8_BAR;
        }
        E(acc, cur, wr, wc, fr, fq);
        if (!has_next) break;
#pragma unroll
        for (int a = 0; a < 2; ++a)
#pragma unroll
            for (int b = 0; b < 2; ++b)
#pragma unroll
                for (int m = 0; m < 4; ++m)
#pragma unroll
                    for (int n = 0; n < 2; ++n) acc[a][b][m][n] = (f32x4){0.f, 0.f, 0.f, 0.f};
        cur = nxt; cA = nA; cB = nB; ++ui;
    }
    PG8_WAIT_V(0);
    if (wr == 0) PG8_BAR;
    PG8_BAR;
#undef PG8_SA
#undef PG8_SB
#undef PG8_STAGE
#undef PG8_LDA
#undef PG8_LDB
#undef PG8_MMA
#undef PG8_UA
#undef PG8_UB
}
}
using pg8::Unit;
typedef const f32x4 (&AccRef)[2][2][4][2];
#define EPI_ROWS _Pragma("unroll") for (int ai = 0; ai < 2; ++ai) _Pragma("unroll") for (int m = 0; m < 4; ++m) if ((__builtin_amdgcn_sched_barrier(0), true))
#define EPI_ROW (u.pm * 256 + ai * 128 + wr * 64 + m * 16 + fr)
#define EPI_COLS _Pragma("unroll") for (int bj = 0; bj < 2; ++bj) _Pragma("unroll") for (int n = 0; n < 2; ++n)
#define EPI_CC (bj * 128 + wc * 32 + n * 16 + fq * 4)

struct EpiFfnUp { bf16_t* H;
    DEV void operator()(AccRef acc, const Unit& u, int wr, int wc, int fr, int fq) const {
        EPI_ROWS { const int row = EPI_ROW;
#pragma unroll
            for (int bj = 0; bj < 2; ++bj) { const int col = (u.pn * 8 + bj * 4 + wc) * 16 + fq * 4; const f32x4 a = acc[ai][bj][m][0], b = acc[ai][bj][m][1];
                uint2 o; o.x = pack2(siluf_(a[0]) * b[0], siluf_(a[1]) * b[1]); o.y = pack2(siluf_(a[2]) * b[2], siluf_(a[3]) * b[3]);
                *(uint2*)(H + (size_t)row * DFF + col) = o; } }
    } };
struct EpiResid { float* X; const float* XS; float s; const float2* st; const float* g; const float* b;
    DEV void operator()(AccRef acc, const Unit& u, int wr, int wc, int fr, int fq) const {
        const int row0 = u.pm * 256 + wr * 64 + fr;
        float mu[8], rs[8];
#pragma unroll
        for (int r = 0; r < 8; ++r) { mu[r] = 0.f; rs[r] = 1.f; if (st) { const float2 t = st[row0 + (r >> 2) * 128 + (r & 3) * 16]; mu[r] = t.x; rs[r] = t.y; } }
#pragma unroll
        for (int bj = 0; bj < 2; ++bj)
#pragma unroll
            for (int n = 0; n < 2; ++n) { __builtin_amdgcn_sched_barrier(0);
                const int col = u.pn * 256 + EPI_CC; f32x4 gv = {1.f, 1.f, 1.f, 1.f}, bv = {0.f, 0.f, 0.f, 0.f};
                if (st) { gv = *(const f32x4*)(g + col); bv = *(const f32x4*)(b + col); }
#pragma unroll
                for (int r = 0; r < 8; ++r) { const int ai = r >> 2, m = r & 3; const size_t eo = (size_t)(row0 + ai * 128 + m * 16) * DM + col; f32x4* p = (f32x4*)(X + eo); f32x4 v = *(const f32x4*)(XS + eo);
                    if (st) v = (v - mu[r]) * rs[r] * gv + bv;
                    *p = v * ALPHA + acc[ai][bj][m][n] * s; } }
    } };
struct EpiF32 { float* C; int ldc;
    DEV void operator()(AccRef acc, const Unit& u, int wr, int wc, int fr, int fq) const {
        EPI_ROWS { float* rp = C + (size_t)EPI_ROW * ldc + u.pn * 256;
            EPI_COLS { *(f32x4*)(rp + EPI_CC) = acc[ai][bj][m][n]; } }
    } };
struct EpiRetQKV { bf16_t *Q, *Kr, *Kt, *Vt; const float2* cs;
    DEV void operator()(AccRef acc, const Unit& u, int wr, int wc, int fr, int fq) const {
        const int pn = u.pn;
        if (pn < 8) {
            const int h = pn & 3; const bool isk = pn >= 4;
            const float lg2 = log2f(1.0f - exp2f(-5.0f - (float)h));
            EPI_ROWS { const int row = EPI_ROW, t = row & (TSEQ - 1), b = row >> 14;
                const float kdec = exp2f((float)(127 - (t & 127)) * lg2) * 0.0625f;
#pragma unroll
                for (int n = 0; n < 2; ++n) { const int j = wc * 32 + n * 16 + fq * 4; float o1[4], o2[4];
#pragma unroll
                    for (int i = 0; i < 4; ++i) { const float2 c = cs[(size_t)t * 128 + j + i]; const float t1 = acc[ai][0][m][n][i], t2 = acc[ai][1][m][n][i]; o1[i] = t1 * c.x - t2 * c.y; o2[i] = t1 * c.y + t2 * c.x; }
                    if (!isk) { bf16_t* p = Q + (size_t)row * 1024 + h * 256 + j; uint2 a, bb; a.x = pack2(o1[0], o1[1]); a.y = pack2(o1[2], o1[3]); bb.x = pack2(o2[0], o2[1]); bb.y = pack2(o2[2], o2[3]);
                        *(uint2*)p = a; *(uint2*)(p + 128) = bb; }
                    else { bf16_t* p = Kr + (size_t)row * 1024 + h * 256 + j; uint2 a, bb; a.x = pack2(o1[0] * 0.0625f, o1[1] * 0.0625f); a.y = pack2(o1[2] * 0.0625f, o1[3] * 0.0625f);
                        bb.x = pack2(o2[0] * 0.0625f, o2[1] * 0.0625f); bb.y = pack2(o2[2] * 0.0625f, o2[3] * 0.0625f); *(uint2*)p = a; *(uint2*)(p + 128) = bb;
                        bf16_t* pt = Kt + ((size_t)(((b * 4 + h) * 128 + (t >> 7)) * 256 + j)) * 128 + (t & 127);
#pragma unroll
                        for (int i = 0; i < 4; ++i) { pt[i * 128] = f2bf(o1[i] * kdec); pt[(i + 128) * 128] = f2bf(o2[i] * kdec); } } } }
        } else {
            const int h = (pn - 8) >> 1, eb = ((pn - 8) & 1) * 256;
            EPI_ROWS { const int row = EPI_ROW, t = row & (TSEQ - 1), b = row >> 14;
                EPI_COLS { const int e = eb + EPI_CC; bf16_t* pt = Vt + ((size_t)(((b * 4 + h) * 128 + (t >> 7)) * 512 + e)) * 128 + (t & 127);
#pragma unroll
                    for (int i = 0; i < 4; ++i) pt[i * 128] = f2bf(acc[ai][bj][m][n][i]); } }
        }
    } };
struct EpiMulBf { bf16_t* O; int ldo; int mode;
    bf16_t* O2;
    DEV void operator()(AccRef acc, const Unit& u, int wr, int wc, int fr, int fq) const {
        EPI_ROWS { const size_t ro = (size_t)EPI_ROW * ldo + u.pn * 256;
            EPI_COLS { const uint2 v = *(const uint2*)(O + ro + EPI_CC); const f32x4 a = acc[ai][bj][m][n]; float f[4] = {bf2f((bf16_t)(v.x & 0xffff)), bf2f((bf16_t)(v.x >> 16)), bf2f((bf16_t)(v.y & 0xffff)), bf2f((bf16_t)(v.y >> 16))};
                float r[4];
#pragma unroll
                for (int i = 0; i < 4; ++i) r[i] = mode == 0 ? siluf_(a[i]) * f[i] : f[i] * sigmoidf_(a[i]);
                uint2 o; o.x = pack2(r[0], r[1]); o.y = pack2(r[2], r[3]); *(uint2*)((mode == 0 ? O : O2) + ro + EPI_CC) = o; } }
    } };
struct EpiRw1 { bf16_t *R, *L;
    DEV void operator()(AccRef acc, const Unit& u, int wr, int wc, int fr, int fq) const {
        const int pn = u.pn;
        EPI_ROWS { const int row = EPI_ROW;
            EPI_COLS { const int cc = EPI_CC; f32x4 a = acc[ai][bj][m][n]; uint2 o;
                if (pn < 12) { bf16_t* dst = R + (size_t)(pn >> 2) * (UNIT / 2); o.x = pack2(a[0], a[1]); o.y = pack2(a[2], a[3]); *(uint2*)(dst + (size_t)row * 1024 + (pn & 3) * 256 + cc) = o; }
                else { float r[4];
#pragma unroll
                    for (int i = 0; i < 4; ++i) r[i] = bj == 1 ? sigmoidf_(a[i]) : (wc < 2 ? tanhf_(a[i]) : a[i]);
                    o.x = pack2(r[0], r[1]); o.y = pack2(r[2], r[3]); *(uint2*)(L + (size_t)row * 256 + cc) = o; } } }
    } };
struct EpiRw2 { bf16_t *EW; const float *w0, *a0;
    DEV void operator()(AccRef acc, const Unit& u, int wr, int wc, int fr, int fq) const {
        const int pn = u.pn;
        EPI_ROWS { const int row = EPI_ROW;
            EPI_COLS { __builtin_amdgcn_sched_barrier(0); const int c = (pn & 3) * 256 + EPI_CC; f32x4 a = acc[ai][bj][m][n]; float r[4];
                if (pn < 4) { const f32x4 w = *(const f32x4*)(w0 + c);
#pragma unroll
                    for (int i = 0; i < 4; ++i) r[i] = 0.6065306597126334f * sigmoidf_(w[i] + a[i]); }
                else if (pn < 8) { const f32x4 w = *(const f32x4*)(a0 + c);
#pragma unroll
                    for (int i = 0; i < 4; ++i) r[i] = sigmoidf_(w[i] + a[i]); }
                else {
#pragma unroll
                    for (int i = 0; i < 4; ++i) r[i] = a[i]; }
                uint2 o; o.x = pack2(r[0], r[1]); o.y = pack2(r[2], r[3]); *(uint2*)(EW + (size_t)(pn >> 2) * (UNIT / 2) + (size_t)row * 1024 + c) = o; } }
    } };
struct EpiLruIn { bf16_t *GATE, *XR;
    DEV void operator()(AccRef acc, const Unit& u, int wr, int wc, int fr, int fq) const {
        const int pn = u.pn;
        EPI_ROWS { const int row = EPI_ROW;
            EPI_COLS { const int c = (pn & 3) * 256 + EPI_CC; f32x4 a = acc[ai][bj][m][n]; uint2 o;
                if (pn < 4) { o.x = pack2(geluf_(a[0]), geluf_(a[1])); o.y = pack2(geluf_(a[2]), geluf_(a[3])); *(uint2*)(GATE + (size_t)row * 1024 + c) = o; }
                else { o.x = pack2(a[0], a[1]); o.y = pack2(a[2], a[3]); *(uint2*)(XR + (size_t)row * 1024 + c) = o; } } }
    } };
struct EpiLruAx { unsigned* PK; const bf16_t* XC; const float *ba, *bx, *lam;
    DEV void operator()(AccRef acc, const Unit& u, int wr, int wc, int fr, int fq) const {
        const int pn = u.pn;
        EPI_ROWS { const int row = EPI_ROW;
#pragma unroll
            for (int bj = 0; bj < 2; ++bj) { __builtin_amdgcn_sched_barrier(0); const int ch = (pn >> 1) * 256 + ((pn & 1) * 8 + bj * 4 + wc) * 16 + fq * 4;
                const f32x4 ga = acc[ai][bj][m][0], gx = acc[ai][bj][m][1]; const f32x4 vba = *(const f32x4*)(ba + ch), vbx = *(const f32x4*)(bx + ch), vl = *(const f32x4*)(lam + ch);
                const uint2 xv = *(const uint2*)(XC + (size_t)row * 1024 + ch); const float xf[4] = {bf2f((bf16_t)(xv.x & 0xffff)), bf2f((bf16_t)(xv.x >> 16)), bf2f((bf16_t)(xv.y & 0xffff)), bf2f((bf16_t)(xv.y >> 16))};
                unsigned ow[4];
#pragma unroll
                for (int i = 0; i < 4; ++i) { const float r = sigmoidf_(ga[i] + vba[i]), it = sigmoidf_(gx[i] + vbx[i]);
                    const float la = -8.0f * r * softplus_neg(vl[i]); ow[i] = pack2(neg_expm1(la), sqrtf(neg_expm1(2.0f * la)) * (it * xf[i])); }
                *(uint4*)(PK + (size_t)row * 1024 + ch) = make_uint4(ow[0], ow[1], ow[2], ow[3]); } }
    } };

DEV void cvt_t(const int wid_s_, float* lf, bf16_t* dst, int dld, int dn0, int dk0, const float* src, int sld, int sc0, int N, int K, const float* ks, int perm) {
    const int tn = N >> 6, tiles = tn * (K >> 6), tid = otid(), G = gridDim.x;
    for (int tile0 = obid(); tile0 < tiles; tile0 += G * 4) {
#pragma unroll
        for (int u = 0; u < 4; ++u) { const int tile = tile0 + u * G; if (tile < tiles) { const int n0 = (tile % tn) * 64, k0 = (tile / tn) * 64;
#pragma unroll
            for (int i = 0; i < 8; ++i) { const int kk = (tid >> 6) + 8 * i, nn = tid & 63; float v = src[(size_t)(k0 + kk) * sld + sc0 + n0 + nn]; if (ks) v *= ks[k0 + kk]; lf[u * 4160 + kk * 65 + nn] = v; } } }
        __syncthreads();
#pragma unroll
        for (int u = 0; u < 4; ++u) { const int tile = tile0 + u * G; if (tile < tiles) { const int n0 = (tile % tn) * 64, k0 = (tile / tn) * 64;
#pragma unroll
            for (int i = 0; i < 8; ++i) { const int nn = (tid >> 6) + 8 * i, kk = tid & 63, n = n0 + nn; const int pn = perm < 0 ? n : ((n >> 4) * 32 + perm * 16 + (n & 15));
                dst[(size_t)(dn0 + pn) * dld + dk0 + k0 + kk] = f2bf(lf[u * 4160 + kk * 65 + nn]); } } }
        __syncthreads();
    }
}
DEV void fill0(const int wid_s_, bf16_t* dst, int dld, int n0, int k0, int N, int K) {
    const int per = K >> 3; const long tot = (long)N * per;
    for (long i = (long)obid() * blockDim.x + otid(); i < tot; i += (long)gridDim.x * blockDim.x) { const int n = (int)(i / per), k = (int)(i % per) * 8; *(uint4*)(dst + (size_t)(n0 + n) * dld + k0 + k) = make_uint4(0, 0, 0, 0); }
}
constexpr size_t W_UP0 = 0, W_DN0 = 5767168, W_UP1 = 8650752, W_DN1 = 14417920, W_MIX = 17301504;
DEV void convert_layer(const int wid_s_, CP p, int layer, float* lf) {
    bf16_t* W = (bf16_t*)p->ws;
    for (int s = 0; s < 2; ++s) { const size_t wo = (size_t)(layer * 2 + s) * 1024 * DFF;
        cvt_t(wid_s_, lf, W + (s ? W_UP1 : W_UP0), 1024, 0, 0, p->in[I_W1] + wo, DFF, 0, DFF, 1024, nullptr, 0);
        cvt_t(wid_s_, lf, W + (s ? W_UP1 : W_UP0), 1024, 0, 0, p->in[I_W3] + wo, DFF, 0, DFF, 1024, nullptr, 1);
        cvt_t(wid_s_, lf, W + (s ? W_DN1 : W_DN0), DFF, 0, 0, p->in[I_W2] + wo, 1024, 0, 1024, DFF, nullptr, -1); }
    bf16_t* X = W + W_MIX;
    if (layer == 0) { cvt_t(wid_s_, lf, X, 1024, 0, 0, p->in[I_RET_IN], 6144, 0, 6144, 1024, nullptr, -1); cvt_t(wid_s_, lf, X + 6291456, 2048, 0, 0, p->in[I_RET_OUT], 1024, 0, 1024, 2048, nullptr, -1); }
    else if (layer == 1) { cvt_t(wid_s_, lf, X, 1024, 0, 0, p->in[I_S5_IN], 1024, 0, 1024, 1024, nullptr, -1); cvt_t(wid_s_, lf, X + 1048576, 1024, 0, 0, p->in[I_S5_GLU], 1024, 0, 1024, 1024, nullptr, -1);
        cvt_t(wid_s_, lf, X + 2097152, 1024, 0, 0, p->in[I_S5_OUT], 1024, 0, 1024, 1024, nullptr, -1); }
    else if (layer == 2) { const float* mu = p->in[I_RW_MU];
        const float* srcs[6] = {p->in[I_RW_R], p->in[I_RW_K], p->in[I_RW_V], p->in[I_RW_W1], p->in[I_RW_A1], p->in[I_RW_G1]};
        const int mus[6] = {0, 2, 3, 1, 4, 5}, n0s[6] = {0, 1024, 2048, 3072, 3136, 3200}, ns[6] = {1024, 1024, 1024, 64, 64, 128};
#pragma unroll
        for (int q = 0; q < 6; ++q) { cvt_t(wid_s_, lf, X, 2048, n0s[q], 0, srcs[q], ns[q], 0, ns[q], 1024, nullptr, -1); cvt_t(wid_s_, lf, X + 0, 2048, n0s[q], 1024, srcs[q], ns[q], 0, ns[q], 1024, mu + mus[q] * 1024, -1); }
        bf16_t* X2 = X + 6815744;
        cvt_t(wid_s_, lf, X2, 256, 0, 0, p->in[I_RW_W2], 1024, 0, 1024, 64, nullptr, -1); cvt_t(wid_s_, lf, X2, 256, 1024, 64, p->in[I_RW_A2], 1024, 0, 1024, 64, nullptr, -1); cvt_t(wid_s_, lf, X2, 256, 2048, 128, p->in[I_RW_G2], 1024, 0, 1024, 128, nullptr, -1);
        fill0(wid_s_, X2, 256, 0, 64, 1024, 192); fill0(wid_s_, X2, 256, 1024, 0, 1024, 64); fill0(wid_s_, X2, 256, 1024, 128, 1024, 128); fill0(wid_s_, X2, 256, 2048, 0, 1024, 128);
        cvt_t(wid_s_, lf, X + 7602176, 1024, 0, 0, p->in[I_RW_O], 1024, 0, 1024, 1024, nullptr, -1); }
    else { cvt_t(wid_s_, lf, X, 1024, 0, 0, p->in[I_LRU_IN], 2048, 0, 2048, 1024, nullptr, -1);
        for (int blk = 0; blk < 4; ++blk) { cvt_t(wid_s_, lf, X + 2097152, 256, blk * 512, 0, p->in[I_LRU_WA] + blk * 65536, 256, 0, 256, 256, nullptr, 0); cvt_t(wid_s_, lf, X + 2097152, 256, blk * 512, 0, p->in[I_LRU_WX] + blk * 65536, 256, 0, 256, 256, nullptr, 1); }
        cvt_t(wid_s_, lf, X + 2621440, 1024, 0, 0, p->in[I_LRU_OUT], 1024, 0, 1024, 1024, nullptr, -1); }
}

DEV void ln_phase(const int wid_s_, float* X, bf16_t* XB, const float* g, const float* b, float2* st, const bool write_x) {
    const int lane = otid() & 63, wv = otid() >> 6;
    f32x4 gv[4], bv[4];
#pragma unroll
    for (int j = 0; j < 4; ++j) { gv[j] = *(const f32x4*)(g + j * 256 + lane * 4); bv[j] = *(const f32x4*)(b + j * 256 + lane * 4); }
    for (int row = obid() * 8 + wv; row < M_TOK; row += gridDim.x * 8) {
        float* rp = X + (size_t)row * DM; f32x4 v[4]; float s = 0.f;
#pragma unroll
        for (int j = 0; j < 4; ++j) { v[j] = *(const f32x4*)(rp + j * 256 + lane * 4); s += v[j][0] + v[j][1] + v[j][2] + v[j][3]; }
        const float mu = wave_sum_fast(s) * (1.0f / DM); float q = 0.f;
#pragma unroll
        for (int j = 0; j < 4; ++j) { v[j] = v[j] - mu; q += v[j][0] * v[j][0] + v[j][1] * v[j][1] + v[j][2] * v[j][2] + v[j][3] * v[j][3]; }
        const float rs = rsqrtf(wave_sum_fast(q) * (1.0f / DM) + 1e-5f);
        if (lane == 0) st[row] = make_float2(mu, rs);
#pragma unroll
        for (int j = 0; j < 4; ++j) { f32x4 o = v[j] * rs * gv[j] + bv[j]; if (write_x) *(f32x4*)(rp + j * 256 + lane * 4) = o;
            uint2 pk; pk.x = pack2(o[0], o[1]); pk.y = pack2(o[2], o[3]); *(uint2*)(XB + (size_t)row * DM + j * 256 + lane * 4) = pk; }
    }
}

DEV void ln_prep_phase(const int wid_s_, const float* X, bf16_t* A2, const float* g, const float* b, float2* st) {
    const int lane = otid() & 63, wv = otid() >> 6;
    f32x4 gv[4], bv[4];
#pragma unroll
    for (int j = 0; j < 4; ++j) { gv[j] = *(const f32x4*)(g + j * 256 + lane * 4); bv[j] = *(const f32x4*)(b + j * 256 + lane * 4); }
    for (int r0 = (obid() * 8 + wv) * 16; r0 < M_TOK; r0 += gridDim.x * 8 * 16) {
        f32x4 prev[4], cur[4], nxt[4];
        const bool has_prev = (r0 & (TSEQ - 1)) != 0; const int first = has_prev ? r0 - 1 : r0;
#pragma unroll
        for (int j = 0; j < 4; ++j) { nxt[j] = *(const f32x4*)(X + (size_t)first * DM + j * 256 + lane * 4); prev[j] = (f32x4){0.f, 0.f, 0.f, 0.f}; }
        for (int row = first; row < r0 + 16; ++row) {
#pragma unroll
            for (int j = 0; j < 4; ++j) cur[j] = nxt[j];
            if (row + 1 < r0 + 16) {
#pragma unroll
                for (int j = 0; j < 4; ++j) nxt[j] = *(const f32x4*)(X + (size_t)(row + 1) * DM + j * 256 + lane * 4); }
            float s = 0.f;
#pragma unroll
            for (int j = 0; j < 4; ++j) s += cur[j][0] + cur[j][1] + cur[j][2] + cur[j][3];
            const float mu = wave_sum_fast(s) * (1.0f / DM); float q = 0.f;
#pragma unroll
            for (int j = 0; j < 4; ++j) { cur[j] = cur[j] - mu; q += cur[j][0] * cur[j][0] + cur[j][1] * cur[j][1] + cur[j][2] * cur[j][2] + cur[j][3] * cur[j][3]; }
            const float rs = rsqrtf(wave_sum_fast(q) * (1.0f / DM) + 1e-5f);
#pragma unroll
            for (int j = 0; j < 4; ++j) cur[j] = cur[j] * rs * gv[j] + bv[j];
            if (row >= r0) {
                if (lane == 0) st[row] = make_float2(mu, rs);
#pragma unroll
                for (int j = 0; j < 4; ++j) { uint2 o; o.x = pack2(cur[j][0], cur[j][1]); o.y = pack2(cur[j][2], cur[j][3]); *(uint2*)(A2 + (size_t)row * 2048 + j * 256 + lane * 4) = o;
                    const f32x4 d = prev[j] - cur[j]; o.x = pack2(d[0], d[1]); o.y = pack2(d[2], d[3]); *(uint2*)(A2 + (size_t)row * 2048 + 1024 + j * 256 + lane * 4) = o; } }
#pragma unroll
            for (int j = 0; j < 4; ++j) prev[j] = cur[j];
        }
    }
}

DEV void ret_s_phase(const int wid_s_, const bf16_t* Q, const bf16_t* Kr, bf16_t* Sb) {
    const int lane = otid() & 63, w = otid() >> 6, fr = lane & 15, fq = lane >> 4;
    for (int item = obid(); item < 1024; item += gridDim.x) {
        const int h = item & 3, c = (item >> 2) & 127, b = item >> 9; const size_t rowbase = (size_t)b * TSEQ + c * 128;
        const float lg2 = log2f(1.0f - exp2f(-5.0f - (float)h));
        bf16x8 yq[8];
#pragma unroll
        for (int ks = 0; ks < 8; ++ks) yq[ks] = *(const bf16x8*)(Q + (rowbase + 16 * w + fr) * 1024 + h * 256 + ks * 32 + fq * 8);
        bf16_t* So = Sb + (size_t)item * 16384;
        const int ii = 16 * w + fr;
        for (int jt = 0; jt <= w; ++jt) {
            f32x4 acc = {0.f, 0.f, 0.f, 0.f};
#pragma unroll
            for (int ks = 0; ks < 8; ++ks) { const bf16x8 xk = *(const bf16x8*)(Kr + (rowbase + 16 * jt + fr) * 1024 + h * 256 + ks * 32 + fq * 8); acc = __builtin_amdgcn_mfma_f32_16x16x32_bf16(xk, yq[ks], acc, 0, 0, 0); }
            float r[4];
#pragma unroll
            for (int i = 0; i < 4; ++i) { const int jj = 16 * jt + fq * 4 + i; r[i] = (ii >= jj) ? acc[i] * exp2f((float)(ii - jj) * lg2) : 0.f; }
            uint2 o; o.x = pack2(r[0], r[1]); o.y = pack2(r[2], r[3]); *(uint2*)(So + ii * 128 + 16 * jt + fq * 4) = o;
        }
        if (!(w & 1)) *(uint2*)(So + ii * 128 + 16 * (w + 1) + fq * 4) = make_uint2(0, 0);
    }
}
template <int MODE> DEV void ret_scan_phase(const int wid_s_, LAS unsigned char* lds, const bf16_t* Q, const bf16_t* Kt, bf16_t* Vt, const bf16_t* Sb, float* Eseg) {
    const int bid = obid(); if (bid >= 256) return;
    const int lane = otid() & 63, w = otid() >> 6, fr = lane & 15, fq = lane >> 4;
    const int grp = (bid & 7) * 4 + (bid >> 6), et = (bid >> 3) & 7, seg = grp & 3, bh = grp >> 2, b = bh >> 2, h = bh & 3, item = bh * 8 + et, e0 = et * 64;
    if (MODE == 0 && seg == 3) return;
    LAS bf16_t* Rt = (LAS bf16_t*)lds;
    const float lg2 = log2f(1.0f - exp2f(-5.0f - (float)h)); const float cd = exp2f(128.0f * lg2);
    f32x4 racc[4][2];
#pragma unroll
    for (int a = 0; a < 4; ++a) { racc[a][0] = (f32x4){0.f, 0.f, 0.f, 0.f}; racc[a][1] = (f32x4){0.f, 0.f, 0.f, 0.f}; }
    bf16_t* Vh0 = Vt + ((size_t)((b * 4 + h) * 128) * 512 + e0) * 128;
    const bf16_t* Kh0 = Kt + ((size_t)((b * 4 + h) * 128) * 256) * 128;
    bf16x8 vt[4][4], yk[2][4];
    if (MODE == 0) {
        for (int c = seg * 32; c < seg * 32 + 32; ++c) { const bf16_t* Vc = Vh0 + (size_t)c * 512 * 128; const bf16_t* Kc = Kh0 + (size_t)c * 256 * 128;
#pragma unroll
            for (int a = 0; a < 4; ++a)
#pragma unroll
                for (int ks = 0; ks < 4; ++ks) vt[a][ks] = *(const bf16x8*)(Vc + (a * 16 + fr) * 128 + ks * 32 + fq * 8);
#pragma unroll
            for (int dt = 0; dt < 2; ++dt)
#pragma unroll
                for (int ks = 0; ks < 4; ++ks) yk[dt][ks] = *(const bf16x8*)(Kc + (32 * w + 16 * dt + fr) * 128 + ks * 32 + fq * 8);
#pragma unroll
            for (int a = 0; a < 4; ++a) { racc[a][0] *= cd; racc[a][1] *= cd; }
#pragma unroll
            for (int dt = 0; dt < 2; ++dt)
#pragma unroll
                for (int ks = 0; ks < 4; ++ks) {
#pragma unroll
                    for (int a = 0; a < 4; ++a) racc[a][dt] = __builtin_amdgcn_mfma_f32_16x16x32_bf16(vt[a][ks], yk[dt][ks], racc[a][dt], 0, 0, 0); } }
        float* Eo = Eseg + (size_t)(item * 3 + seg) * 16384;
#pragma unroll
        for (int a = 0; a < 4; ++a)
#pragma unroll
            for (int dt = 0; dt < 2; ++dt)
#pragma unroll
                for (int i = 0; i < 4; ++i) Eo[(a * 16 + fq * 4 + i) * 256 + 32 * w + 16 * dt + fr] = racc[a][dt][i];
        return;
    }
    {
        const float cd32 = exp2f(32.0f * 128.0f * lg2); float wgt = 1.0f;
        for (int sp = seg - 1; sp >= 0; --sp) { const float* Ei = Eseg + (size_t)(item * 3 + sp) * 16384;
#pragma unroll
            for (int a = 0; a < 4; ++a)
#pragma unroll
                for (int dt = 0; dt < 2; ++dt)
#pragma unroll
                    for (int i = 0; i < 4; ++i) racc[a][dt][i] += wgt * Ei[(a * 16 + fq * 4 + i) * 256 + 32 * w + 16 * dt + fr];
            wgt *= cd32; }
#pragma unroll
        for (int a = 0; a < 4; ++a)
#pragma unroll
            for (int dt = 0; dt < 2; ++dt)
#pragma unroll
                for (int i = 0; i < 4; ++i) Rt[(a * 16 + fq * 4 + i) * 264 + 32 * w + 16 * dt + fr] = f2bf(racc[a][dt][i]);
    }
    __syncthreads();
    float qd[4];
#pragma unroll
    for (int i = 0; i < 4; ++i) qd[i] = exp2f((float)(16 * w + fq * 4 + i + 1) * lg2);
    const int nks = (16 * w + 15) / 32 + 1;
    bf16x8 xq[8], xs[4];
#define RS_LOAD(c_) do { const int cc_ = (c_); const bf16_t* Vc = Vh0 + (size_t)cc_ * 512 * 128; const bf16_t* Kc = Kh0 + (size_t)cc_ * 256 * 128; const size_t rb = (size_t)b * TSEQ + cc_ * 128; \
        const bf16_t* Sc = Sb + ((size_t)((b * 128 + cc_) * 4 + h)) * 16384; \
        _Pragma("unroll") for (int ks = 0; ks < 8; ++ks) xq[ks] = *(const bf16x8*)(Q + (rb + 16 * w + fr) * 1024 + h * 256 + ks * 32 + fq * 8); \
        _Pragma("unroll") for (int a = 0; a < 4; ++a) _Pragma("unroll") for (int ks = 0; ks < 4; ++ks) vt[a][ks] = *(const bf16x8*)(Vc + (a * 16 + fr) * 128 + ks * 32 + fq * 8); \
        _Pragma("unroll") for (int ks = 0; ks < 4; ++ks) if (ks < nks) xs[ks] = *(const bf16x8*)(Sc + (16 * w + fr) * 128 + ks * 32 + fq * 8); \
        _Pragma("unroll") for (int dt = 0; dt < 2; ++dt) _Pragma("unroll") for (int ks = 0; ks < 4; ++ks) yk[dt][ks] = *(const bf16x8*)(Kc + (32 * w + 16 * dt + fr) * 128 + ks * 32 + fq * 8); } while (0)
    const int c_end = seg * 32 + 32;
    RS_LOAD(seg * 32);
    for (int c = seg * 32; c < c_end; ++c) {
        bf16_t* Vh = Vh0 + (size_t)c * 512 * 128;
        f32x4 oacc[4];
#pragma unroll
        for (int a = 0; a < 4; ++a) oacc[a] = (f32x4){0.f, 0.f, 0.f, 0.f};
#pragma unroll
        for (int ks = 0; ks < 8; ++ks) {
#pragma unroll
            for (int a = 0; a < 4; ++a) { const bf16x8 yr = *(const LAS bf16x8*)(Rt + (a * 16 + fr) * 264 + ks * 32 + fq * 8); oacc[a] = __builtin_amdgcn_mfma_f32_16x16x32_bf16(xq[ks], yr, oacc[a], 0, 0, 0); } }
#pragma unroll
        for (int a = 0; a < 4; ++a)
#pragma unroll
            for (int i = 0; i < 4; ++i) oacc[a][i] *= qd[i];
#pragma unroll
        for (int ks = 0; ks < 4; ++ks) if (ks < nks) {
#pragma unroll
            for (int a = 0; a < 4; ++a) oacc[a] = __builtin_amdgcn_mfma_f32_16x16x32_bf16(xs[ks], vt[a][ks], oacc[a], 0, 0, 0); }
#pragma unroll
        for (int a = 0; a < 4; ++a) { racc[a][0] *= cd; racc[a][1] *= cd; }
#pragma unroll
        for (int dt = 0; dt < 2; ++dt)
#pragma unroll
            for (int ks = 0; ks < 4; ++ks) {
#pragma unroll
                for (int a = 0; a < 4; ++a) racc[a][dt] = __builtin_amdgcn_mfma_f32_16x16x32_bf16(vt[a][ks], yk[dt][ks], racc[a][dt], 0, 0, 0); }
        __syncthreads();
        if (c + 1 < c_end) RS_LOAD(c + 1);
#pragma unroll
        for (int a = 0; a < 4; ++a) { uint2 o; o.x = pack2(oacc[a][0], oacc[a][1]); o.y = pack2(oacc[a][2], oacc[a][3]); *(uint2*)(Vh + (a * 16 + fr) * 128 + 16 * w + fq * 4) = o;
#pragma unroll
            for (int dt = 0; dt < 2; ++dt)
#pragma unroll
                for (int i = 0; i < 4; ++i) Rt[(a * 16 + fq * 4 + i) * 264 + 32 * w + 16 * dt + fr] = f2bf(racc[a][dt][i]); }
        __syncthreads();
    }
#undef RS_LOAD
}
DEV void ret_norm_phase(const int wid_s_, LAS unsigned char* lds, const bf16_t* Ot, bf16_t* ON) {
    LAS bf16_t* T = (LAS bf16_t*)lds;
    const int lane = otid() & 63, w = otid() >> 6, tid = otid();
    for (int item = obid(); item < 2048; item += gridDim.x) {
        const int tt = item & 255, h = (item >> 8) & 3, b = item >> 10; const int t0 = tt * 64;
        { const bf16_t* src = Ot + ((size_t)(((b * 4 + h) * 128 + (tt >> 1)) * 512 + tid)) * 128 + (tt & 1) * 64;
#pragma unroll
            for (int q = 0; q < 8; ++q) { const uint4 v = *(const uint4*)(src + q * 8); LAS unsigned* d = (LAS unsigned*)(T + tid * 66 + q * 8); d[0] = v.x; d[1] = v.y; d[2] = v.z; d[3] = v.w; } }
        __syncthreads();
        for (int k = 0; k < 8; ++k) { const int tk = w * 8 + k; float v[8]; float s = 0.f;
#pragma unroll
            for (int q = 0; q < 8; ++q) { v[q] = bf2f(T[(lane + 64 * q) * 66 + tk]); s += v[q]; }
            const float mu = wave_sum(s) * (1.0f / 512.0f); float qq = 0.f;
#pragma unroll
            for (int q = 0; q < 8; ++q) { v[q] -= mu; qq += v[q] * v[q]; }
            const float rs = rsqrtf(wave_sum(qq) * (1.0f / 512.0f) + 1e-5f);
            bf16_t* dst = ON + ((size_t)b * TSEQ + t0 + tk) * 2048 + h * 512;
#pragma unroll
            for (int q = 0; q < 8; ++q) dst[lane + 64 * q] = f2bf(v[q] * rs); }
        __syncthreads();
    }
}

struct S5Coef { float are, aim; float bre[16], bim[16]; };
constexpr size_t S5TAB_OFF = 56ull << 20;
DEV void s5_build_table(const int wid_s_, CP p, float* tab) {
    for (int gn = obid() * 512 + otid(); gn < 4096; gn += gridDim.x * 512) { const int g = gn >> 6;
        const double dt = exp((double)p->in[I_S5_LS][g]); const double ar = p->in[I_S5_ARE][gn], ai = p->in[I_S5_AIM][gn];
        const double mag = exp(dt * ar); double sn, cs; sincos(dt * ai, &sn, &cs);
        const double abr = mag * cs, abi = mag * sn, den = ar * ar + ai * ai;
        const double fre = ((abr - 1.0) * ar + abi * ai) / den, fim = (abi * ar - (abr - 1.0) * ai) / den;
        float* t = tab + (size_t)gn * 36; t[0] = (float)abr; t[1] = (float)abi;
        const double mL = exp(64.0 * dt * ar); double s2, c2; sincos(64.0 * dt * ai, &s2, &c2); t[2] = (float)(mL * c2); t[3] = (float)(mL * s2);
        for (int q = 0; q < 16; ++q) { const double br = p->in[I_S5_BRE][gn * 16 + q], bi = p->in[I_S5_BIM][gn * 16 + q]; t[4 + q] = (float)(fre * br - fim * bi); t[20 + q] = (float)(fre * bi + fim * br); } }
}
DEV void s5_coef(CP p, int g, int n, S5Coef& c, float* aLre, float* aLim) {
    const float* t = (const float*)(p->ws + S5TAB_OFF) + (size_t)(g * 64 + n) * 36;
    const f32x4 h = *(const f32x4*)t; c.are = h[0]; c.aim = h[1]; if (aLre) { *aLre = h[2]; *aLim = h[3]; }
#pragma unroll
    for (int q4 = 0; q4 < 4; ++q4) { const f32x4 a = *(const f32x4*)(t + 4 + q4 * 4), b = *(const f32x4*)(t + 20 + q4 * 4);
#pragma unroll
        for (int i = 0; i < 4; ++i) { c.bre[q4 * 4 + i] = a[i]; c.bim[q4 * 4 + i] = b[i]; } }
}
template <bool OUT> DEV void s5_scan_phase(const int wid_s_, CP p, LAS unsigned char* lds, const float* U, float2* E, bf16_t* ACT) {
    const int lane = otid() & 63, w = wid_s_, fr = lane & 15, fq = lane >> 4; const int g = (obid() & 7) * 8 + w;
    S5Coef cf; s5_coef(p, g, lane, cf, nullptr, nullptr);
    typedef float f32x2s __attribute__((ext_vector_type(2)));
    f32x2s cb[16];
#pragma unroll
    for (int q = 0; q < 16; ++q) cb[q] = (f32x2s){cf.bre[q], cf.bim[q]};
    LAS bf16_t* hb = (LAS bf16_t*)lds + w * (16 * 136);
    bf16x8 cfrag[4]; float dsk = 0.f;
    if (OUT) { dsk = p->in[I_S5_D][g * 16 + fr];
#pragma unroll
        for (int ks = 0; ks < 4; ++ks) { const bool im = ks >= 2; const float* src = (im ? p->in[I_S5_CIM] : p->in[I_S5_CRE]) + (g * 16 + fr) * 64 + (ks & 1) * 32 + fq * 8;
#pragma unroll
            for (int i = 0; i < 8; ++i) cfrag[ks][i] = (short)f2bf(im ? -src[i] : src[i]); } }
    for (int item = obid(); item < 4096; item += gridDim.x) {
        const int ch = (item >> 3) & 255, b = item >> 11; const size_t row0 = (size_t)b * TSEQ + ch * 64;
        float hre = 0.f, him = 0.f; const size_t eidx = ((size_t)(b * 256 + ch) * 64 + g) * 64 + lane;
        if (OUT) { const float2 h0 = E[eidx]; hre = h0.x; him = h0.y; }
        for (int t16 = 0; t16 < 64; t16 += 16) {
#pragma unroll 4
            for (int tt = 0; tt < 16; ++tt) { const float* up = U + (row0 + t16 + tt) * 1024 + g * 16; f32x2s bu = {0.f, 0.f};
#pragma unroll
                for (int q4 = 0; q4 < 4; ++q4) { const f32x4 uv = *(const f32x4*)(up + q4 * 4);
#pragma unroll
                    for (int i = 0; i < 4; ++i) bu += cb[q4 * 4 + i] * uv[i]; }
                const float nr = cf.are * hre - cf.aim * him + bu[0], ni = cf.are * him + cf.aim * hre + bu[1]; hre = nr; him = ni;
                if (OUT) { hb[tt * 136 + lane] = f2bf(hre); hb[tt * 136 + 64 + lane] = f2bf(him); } }
            if (OUT) { f32x4 acc = {0.f, 0.f, 0.f, 0.f};
#pragma unroll
                for (int ks = 0; ks < 4; ++ks) { const bf16x8 hf = *(const LAS bf16x8*)(hb + fr * 136 + ks * 32 + fq * 8); acc = __builtin_amdgcn_mfma_f32_16x16x32_bf16(hf, cfrag[ks], acc, 0, 0, 0); }
#pragma unroll
                for (int i = 0; i < 4; ++i) { const size_t o = (row0 + t16 + fq * 4 + i) * 1024 + g * 16 + fr; ACT[o] = f2bf(geluf_(acc[i] + dsk * U[o])); } }
        }
        if (!OUT) E[eidx] = make_float2(hre, him);
    }
}
DEV void s5_carry_phase(const int wid_s_, CP p, float2* E) {
    const int gid = obid() * 512 + otid(); if (gid >= 8192) return;
    const int b = gid >> 12, gn = gid & 4095; S5Coef cf; float are, aim; s5_coef(p, gn >> 6, gn & 63, cf, &are, &aim);
    float hre = 0.f, him = 0.f; float2* e = E + (size_t)b * 256 * 4096 + gn;
    for (int c0 = 0; c0 < 256; c0 += 8) { float2 v[8];
#pragma unroll
        for (int k = 0; k < 8; ++k) v[k] = e[(size_t)(c0 + k) * 4096];
#pragma unroll
        for (int k = 0; k < 8; ++k) { e[(size_t)(c0 + k) * 4096] = make_float2(hre, him); const float nr = are * hre - aim * him + v[k].x, ni = are * him + aim * hre + v[k].y; hre = nr; him = ni; } }
}

DEV void rw_prep_phase(const int wid_s_, const float* X, bf16_t* A2, const float2* st, const float* g, const float* b) {
    for (long i = (long)obid() * 512 + otid(); i < (long)M_TOK * 256; i += (long)gridDim.x * 512) {
        const int row = (int)(i >> 8), c = (int)(i & 255) * 4; const f32x4 gv = *(const f32x4*)(g + c), bv = *(const f32x4*)(b + c);
        const float2 t = st[row]; const f32x4 v = (*(const f32x4*)(X + (size_t)row * 1024 + c) - t.x) * t.y * gv + bv;
        f32x4 pv = {0.f, 0.f, 0.f, 0.f}; if (row & (TSEQ - 1)) { const float2 tp = st[row - 1]; pv = (*(const f32x4*)(X + (size_t)(row - 1) * 1024 + c) - tp.x) * tp.y * gv + bv; }
        uint2 o; o.x = pack2(v[0], v[1]); o.y = pack2(v[2], v[3]); *(uint2*)(A2 + (size_t)row * 2048 + c) = o;
        const f32x4 d = pv - v; o.x = pack2(d[0], d[1]); o.y = pack2(d[2], d[3]); *(uint2*)(A2 + (size_t)row * 2048 + 1024 + c) = o;
    }
}
DEV void rw_scan_phase(const int wid_s_, CP p, LAS unsigned char* lds, const bf16_t* R, const bf16_t* Kk, const bf16_t* V, const bf16_t* EW, const bf16_t* AA, bf16_t* Y) {
    const int bid = obid(); if (bid >= 256) return;
    const int bh = (bid & 7) * 4 + (bid >> 6), rg = (bid >> 3) & 7, b = bh >> 4, h = bh & 15;
    const int tid = otid();
    constexpr int TC = 32, BUF = 5 * TC * 64 + TC * 8, NCH = TSEQ / TC;
    LAS float* L0 = (LAS float*)lds; LAS float* YB = L0 + 2 * BUF;
    const bool isprod = (wid_s_ & 2) != 0; const int pw = (wid_s_ >> 2) * 2 + (wid_s_ & 1), pl = tid & 63, pt = pw * 64 + pl, phalf = pl >> 5, pc2 = (pl & 31) * 2;
    float kkw0 = 0.f, kkw1 = 0.f, kaw0 = 0.f, kaw1 = 0.f;
    if (isprod) { kkw0 = p->in[I_RW_KK][h * 64 + pc2]; kkw1 = p->in[I_RW_KK][h * 64 + pc2 + 1]; kaw0 = p->in[I_RW_KA][h * 64 + pc2]; kaw1 = p->in[I_RW_KA][h * 64 + pc2 + 1]; }
    unsigned pk[4], pa[4], pew[4], pr[4], pv[4];
    auto pload = [&](int c) {
#pragma unroll
        for (int i = 0; i < 4; ++i) { const int tok = pw * 8 + i * 2 + phalf; const size_t g = ((size_t)b * TSEQ + c * TC + tok) * 1024 + h * 64 + pc2;
            pk[i] = *(const unsigned*)(Kk + g); pa[i] = *(const unsigned*)(AA + g); pew[i] = *(const unsigned*)(EW + g); pr[i] = *(const unsigned*)(R + g);
            pv[i] = pc2 < 8 ? *(const unsigned*)(V + g - pc2 + rg * 8 + pc2) : 0u; }
    };
    typedef float f32x2p __attribute__((ext_vector_type(2)));
    auto pstage = [&](int buf) { LAS float* B = L0 + buf * BUF;
#pragma unroll
        for (int i = 0; i < 4; ++i) { const int tok = pw * 8 + i * 2 + phalf;
            const float k0 = __uint_as_float(pk[i] << 16), k1 = __uint_as_float(pk[i] & 0xffff0000u), a0 = __uint_as_float(pa[i] << 16), a1 = __uint_as_float(pa[i] & 0xffff0000u);
            const float e0 = __uint_as_float(pew[i] << 16), e1 = __uint_as_float(pew[i] & 0xffff0000u);
            const float kv0 = k0 * kkw0, kv1 = k1 * kkw1; const float s16 = sum16(kv0 * kv0 + kv1 * kv1);
            const float t0 = rdlane(s16, 0) + rdlane(s16, 16), t1 = rdlane(s16, 32) + rdlane(s16, 48);
            const float rn = __builtin_amdgcn_rsqf(fmaxf(phalf ? t1 : t0, 1e-24f)); const float kk0 = kv0 * rn, kk1 = kv1 * rn;
            LAS float* q = B + tok * 64 + pc2;
            *(LAS f32x2p*)(q + 0 * TC * 64) = (f32x2p){__expf(-e0), __expf(-e1)}; *(LAS f32x2p*)(q + 1 * TC * 64) = (f32x2p){kk0, kk1}; *(LAS f32x2p*)(q + 2 * TC * 64) = (f32x2p){kk0 * a0, kk1 * a1};
            *(LAS f32x2p*)(q + 3 * TC * 64) = (f32x2p){k0 * (1.0f + (a0 - 1.0f) * kaw0), k1 * (1.0f + (a1 - 1.0f) * kaw1)};
            *(LAS f32x2p*)(q + 4 * TC * 64) = (f32x2p){__uint_as_float(pr[i] << 16), __uint_as_float(pr[i] & 0xffff0000u)};
            if (pc2 < 8) *(LAS f32x2p*)(B + 5 * TC * 64 + tok * 8 + pc2) = (f32x2p){__uint_as_float(pv[i] << 16), __uint_as_float(pv[i] & 0xffff0000u)}; }
    };
    auto store_y = [&](int c) { Y[((size_t)b * TSEQ + c * TC + (pt >> 3)) * 1024 + h * 64 + rg * 8 + (pt & 7)] = f2bf(YB[(c & 1) * TC * 8 + pt]); };
    if (isprod) { pload(0); pstage(0); pload(1); }
    __syncthreads();
    typedef float f32x2 __attribute__((ext_vector_type(2)));
    f32x2 Sa = {0.f, 0.f}, Sb2 = {0.f, 0.f}; const int rowi = tid >> 4, c4 = (tid & 15) * 4, l16 = tid & 15;
    const bool sel8 = (l16 & 8) != 0, sel4 = (l16 & 4) != 0, sel2 = (l16 & 2) != 0, sel1 = (l16 & 1) != 0;
    for (int c = 0; c < NCH; ++c) {
        const int buf = c & 1;
        if (isprod) { if (c + 1 < NCH) pstage(buf ^ 1); if (c + 2 < NCH) pload(c + 2); if (c > 0) store_y(c - 1); }
        else if (tid < 128) { LAS float* B = L0 + buf * BUF; LAS float* yb = YB + buf * TC * 8;
            f32x4 w[4], kk[4], bb[4], km[4], rr[4]; float v[4];
#define RW_LOAD(slot, tk) do { w[slot] = *(const LAS f32x4*)(B + 0 * TC * 64 + (tk) * 64 + c4); kk[slot] = *(const LAS f32x4*)(B + 1 * TC * 64 + (tk) * 64 + c4); bb[slot] = *(const LAS f32x4*)(B + 2 * TC * 64 + (tk) * 64 + c4); \
                km[slot] = *(const LAS f32x4*)(B + 3 * TC * 64 + (tk) * 64 + c4); rr[slot] = *(const LAS f32x4*)(B + 4 * TC * 64 + (tk) * 64 + c4); v[slot] = B[5 * TC * 64 + (tk) * 8 + rowi]; } while (0)
#define RW_STEP(slot, j) do { \
                const f32x2 kA = {kk[slot][0], kk[slot][1]}, kB = {kk[slot][2], kk[slot][3]}; const f32x2 wA = {w[slot][0], w[slot][1]}, wB = {w[slot][2], w[slot][3]}; \
                const f32x2 mA = {km[slot][0], km[slot][1]}, mB = {km[slot][2], km[slot][3]}; const f32x2 bA = {bb[slot][0], bb[slot][1]}, bB = {bb[slot][2], bb[slot][3]}; \
                const f32x2 rA = {rr[slot][0], rr[slot][1]}, rB = {rr[slot][2], rr[slot][3]}; \
                const f32x2 pd = Sa * kA + Sb2 * kB; const float sa = -sum16(pd[0] + pd[1]); \
                const f32x2 TA = Sa * wA + mA * v[slot], TB = Sb2 * wB + mB * v[slot]; \
                Sa = TA + bA * sa; Sb2 = TB + bB * sa; \
                const f32x2 py = Sa * rA + Sb2 * rB; yp[j] = py[0] + py[1]; } while (0)
#pragma unroll 1
            for (int t16 = 0; t16 < TC; t16 += 16) {
                float yp[16];
                RW_LOAD(0, t16); RW_LOAD(1, t16 + 1); RW_LOAD(2, t16 + 2);
#pragma unroll
                for (int j = 0; j < 16; j += 4) {
                    if (j + 3 < 16) RW_LOAD(3, t16 + j + 3);
                    RW_STEP(0, j);
                    if (j + 4 < 16) RW_LOAD(0, t16 + j + 4);
                    RW_STEP(1, j + 1);
                    if (j + 5 < 16) RW_LOAD(1, t16 + j + 5);
                    RW_STEP(2, j + 2);
                    if (j + 6 < 16) RW_LOAD(2, t16 + j + 6);
                    RW_STEP(3, j + 3);
                }
                float y8[8], y4[4], y2[2];
#pragma unroll
                for (int q = 0; q < 8; ++q) { const float keep = sel8 ? yp[q + 8] : yp[q], send = sel8 ? yp[q] : yp[q + 8]; y8[q] = keep + dppf<0x140>(send); }
#pragma unroll
                for (int q = 0; q < 4; ++q) { const float keep = sel4 ? y8[q + 4] : y8[q], send = sel4 ? y8[q] : y8[q + 4]; y4[q] = keep + dppf<0x141>(send); }
#pragma unroll
                for (int q = 0; q < 2; ++q) { const float keep = sel2 ? y4[q + 2] : y4[q], send = sel2 ? y4[q] : y4[q + 2]; y2[q] = keep + dppf<0x4E>(send); }
                { const float keep = sel1 ? y2[1] : y2[0], send = sel1 ? y2[0] : y2[1]; yb[(t16 + l16) * 8 + rowi] = keep + dppf<0xB1>(send); }
            }
#undef RW_LOAD
#undef RW_STEP
        }
        __syncthreads();
    }
    if (isprod) store_y(NCH - 1);
}
DEV void rw_post_phase(const int wid_s_, CP p, const bf16_t* Y, bf16_t* R, const bf16_t* Kk, const bf16_t* V, const bf16_t* AA, const bf16_t* G) {
    const int lane = otid() & 63, w = otid() >> 6;
    for (long it = (long)obid() * 8 + w; it < (long)M_TOK * 4; it += (long)gridDim.x * 8) {
        const int hq = (int)(it & 3); const size_t g0 = (size_t)(it >> 2) * 1024 + hq * 256 + lane; const int ch0 = hq * 256 + lane;
        float y[4], r[4], k[4], v[4], a[4], gg[4];
#pragma unroll
        for (int q = 0; q < 4; ++q) { const size_t g = g0 + q * 64; y[q] = bf2f(Y[g]); r[q] = bf2f(R[g]); k[q] = bf2f(Kk[g]); v[q] = bf2f(V[g]); a[q] = bf2f(AA[g]); gg[q] = bf2f(G[g]); }
#pragma unroll
        for (int q = 0; q < 4; ++q) { const int ch = ch0 + q * 64;
            const float mu = wave_sum_fast(y[q]) * (1.0f / 64.0f); const float d = y[q] - mu; const float var = wave_sum_fast(d * d) * (1.0f / 64.0f);
            const float yn = d * rsqrtf(var + 64e-5f) * p->in[I_RW_LG][ch] + p->in[I_RW_LB][ch];
            const float km = k[q] * (1.0f + (a[q] - 1.0f) * p->in[I_RW_KA][ch]); const float bonus = wave_sum_fast(r[q] * km * p->in[I_RW_RK][ch]);
            R[g0 + q * 64] = f2bf((yn + bonus * v[q]) * gg[q]); }
    }
}

DEV void lru_conv_phase(const int wid_s_, CP p, const bf16_t* XR, bf16_t* XC) {
    const float* cw = p->in[I_LRU_CW]; const float* cb = p->in[I_LRU_CB];
    for (long i = (long)obid() * 512 + otid(); i < (long)M_TOK * 128; i += (long)gridDim.x * 512) {
        const int row = (int)(i >> 7), c = (int)(i & 127) * 8, t = row & (TSEQ - 1); float acc[8];
#pragma unroll
        for (int q = 0; q < 8; ++q) acc[q] = cb[c + q];
#pragma unroll
        for (int j = 0; j < 4; ++j) { if (t - 3 + j < 0) continue; const uint4 v = *(const uint4*)(XR + (size_t)(row - 3 + j) * 1024 + c); const unsigned u[4] = {v.x, v.y, v.z, v.w};
#pragma unroll
            for (int q = 0; q < 4; ++q) { acc[2 * q] += cw[j * 1024 + c + 2 * q] * bf2f((bf16_t)(u[q] & 0xffff)); acc[2 * q + 1] += cw[j * 1024 + c + 2 * q + 1] * bf2f((bf16_t)(u[q] >> 16)); } }
        uint4 o; o.x = pack2(acc[0], acc[1]); o.y = pack2(acc[2], acc[3]); o.z = pack2(acc[4], acc[5]); o.w = pack2(acc[6], acc[7]); *(uint4*)(XC + (size_t)row * 1024 + c) = o;
    }
}
template <bool OUT> DEV void lru_scan_phase(const int wid_s_, const unsigned* PK, float2* CP, bf16_t* GATE) {
    for (int item = obid(); item < 1024; item += gridDim.x) {
        const int half = item & 1, chk = (item >> 1) & 255, b = item >> 9; const int ch = half * 512 + otid(); const size_t row0 = (size_t)b * TSEQ + chk * 64;
        const size_t ci = (size_t)(b * 256 + chk) * 1024 + ch;
        float h = 0.f, P = 1.f; if (OUT) h = CP[ci].x;
#pragma unroll 8
        for (int t = 0; t < 64; ++t) { const size_t g = (row0 + t) * 1024 + ch; const unsigned pw = PK[g]; const float a = 1.0f - __uint_as_float(pw << 16), x = __uint_as_float(pw & 0xffff0000u); h = a * h + x; P *= a;
            if (OUT) GATE[g] = f2bf(h * bf2f(GATE[g])); }
        if (!OUT) CP[ci] = make_float2(P, h);
    }
}
DEV void lru_carry_phase(const int wid_s_, float2* CP) {
    const int gid = obid() * 512 + otid(); if (gid >= 2048) return;
    const int b = gid >> 10, ch = gid & 1023; float2* e = CP + (size_t)b * 256 * 1024 + ch; float h = 0.f;
    for (int c0 = 0; c0 < 256; c0 += 8) { float2 v[8];
#pragma unroll
        for (int k = 0; k < 8; ++k) v[k] = e[(size_t)(c0 + k) * 1024];
#pragma unroll
        for (int k = 0; k < 8; ++k) { e[(size_t)(c0 + k) * 1024].x = h; h = v[k].x * h + v[k].y; } }
}

constexpr size_t BAR_OFF = 58ull << 20;
#define XB_TMO      128
#define XB_XCNT(j)  (256  + 64 * (j))
#define XB_XSUB(j)  (1280 + 64 * (j))
#define XB_XGEN(j)  (2304 + 64 * (j))
#define XB_TOP      3328
#define XB_TOPGEN   3392
#define XB_SPIN_CAP (1u << 18)
DEV unsigned xb_ld(unsigned* p) { return __hip_atomic_load(p, __ATOMIC_RELAXED, __HIP_MEMORY_SCOPE_AGENT); }
DEV unsigned xb_add(unsigned* p, unsigned v) { return __hip_atomic_fetch_add(p, v, __ATOMIC_RELAXED, __HIP_MEMORY_SCOPE_AGENT); }
DEV unsigned xb_xcc_id() { return (unsigned)__builtin_amdgcn_s_getreg((3 << 11) | 20) & 0xFu; }
#define XB_SPIN(cond, bar) do { unsigned _sp = 0; while (cond) { __builtin_amdgcn_s_sleep(1); \
    if ((++_sp & 255u) == 0u) { if (xb_ld(&(bar)[XB_TMO])) break; if (_sp > XB_SPIN_CAP) { atomicAdd(&(bar)[XB_TMO], 1u); break; } } } } while (0)
DEV void xcd_complete(unsigned* bar, unsigned x, unsigned& nloc, unsigned& nx) {
    const unsigned G = gridDim.x; unsigned sum, cnt, mine, sp = 0u;
    for (;;) { sum = 0u; cnt = 0u; mine = 0u;
#pragma unroll
        for (unsigned j = 0; j < 16; ++j) { const unsigned c = xb_ld(&bar[XB_XCNT(j)]); sum += c; cnt += (c > 0u) ? 1u : 0u; mine = (j == x) ? c : mine; }
        if (sum == G) break;
        __builtin_amdgcn_s_sleep(1);
        if ((++sp & 255u) == 0u) { if (xb_ld(&bar[XB_TMO])) break; if (sp > XB_SPIN_CAP) { atomicAdd(&bar[XB_TMO], 1u); break; } } }
    nloc = mine > 0u ? mine : 1u; nx = cnt > 0u ? cnt : 1u;
}
DEV void grid_barrier(const int wid_s_, unsigned* bar, volatile LAS unsigned* st) {
    asm volatile("s_waitcnt vmcnt(0)" ::: "memory");
    __syncthreads();
    if (otid() == 0) {
        __builtin_amdgcn_s_waitcnt(0);
        const unsigned x = xb_xcc_id();
        unsigned nloc = st[0], nx = st[1];
        if (nloc == 0u) { xcd_complete(bar, x, nloc, nx); st[0] = nloc; st[1] = nx; }
        const unsigned old = xb_add(&bar[XB_XSUB(x)], 1u);
        const unsigned gen = old / nloc;
        if (old + 1u == (gen + 1u) * nloc) {
            __builtin_amdgcn_fence(__ATOMIC_RELEASE, "agent");
            asm volatile("s_waitcnt vmcnt(0)" ::: "memory");
            const unsigned og = xb_add(&bar[XB_TOP], 1u);
            const unsigned tg = og / nx;
            if (og + 1u == (tg + 1u) * nx) xb_add(&bar[XB_TOPGEN], 1u);
            else XB_SPIN(xb_ld(&bar[XB_TOPGEN]) == tg, bar);
            __builtin_amdgcn_fence(__ATOMIC_ACQUIRE, "agent");
            xb_add(&bar[XB_XGEN(x)], 1u);
            asm volatile("s_waitcnt vmcnt(0)" ::: "memory");
        } else {
            XB_SPIN(xb_ld(&bar[XB_XGEN(x)]) == gen, bar);
            __builtin_amdgcn_fence(__ATOMIC_ACQUIRE, "agent");
            asm volatile("s_waitcnt vmcnt(0)" ::: "memory");
        }
    }
    __syncthreads();
}
template <class T> DEV T* olaunder(T* q) { asm volatile("" : "+s"(q)); return q; }
#define PTRS CP p = (CP)__builtin_amdgcn_kernarg_segment_ptr(); asm volatile("" : "+s"(p)); unsigned char* ws = olaunder(p->ws); float* X = olaunder(p->x); bf16_t* W = (bf16_t*)ws; bf16_t* XB = (bf16_t*)(ws + UNIT); unsigned char* AR = ws + 2 * UNIT; bf16_t* WX = W + W_MIX; \
    (void)X; (void)W; (void)XB; (void)AR; (void)WX;
#define GEMM(A_, lda_, Bt_, K_, N_, agrp_, E_) do { pg8::Gemm g; g.A = (A_); g.Bt = (Bt_); g.lda = (lda_); g.K = (K_); g.nM = M_TOK / 256; g.nN = (N_) / 256; g.a_grp = (agrp_); pg8::gemm_phase(wid_s_, lds, g, E_); } while (0)
#define STATS ((float2*)(ws + (59ull << 20)))
#define LNG_(L) (p->in[I_LNG] + (L) * 1024)
#define LNB_(L) (p->in[I_LNB] + (L) * 1024)
#define CS_ ((float2*)(AR + 5 * UNIT + UNIT / 2))
#define RQ ((bf16_t*)AR)
#define RKr ((bf16_t*)(AR + UNIT))
#define RKt ((bf16_t*)(AR + 2 * UNIT))
#define RVt ((bf16_t*)(AR + 3 * UNIT))
#define RSb ((bf16_t*)(AR + 5 * UNIT))
#define RES ((float*)(AR + 5 * UNIT + 3 * (UNIT / 4)))
#define SU ((float*)AR)
#define SACT ((bf16_t*)(AR + 2 * UNIT))
#define SZ ((bf16_t*)(AR + 3 * UNIT))
#define SE5 ((float2*)(AR + 4 * UNIT))
#define WA2 ((bf16_t*)AR)
#define WR ((bf16_t*)(AR + 3 * UNIT))
#define WK ((bf16_t*)(AR + 4 * UNIT))
#define WV ((bf16_t*)(AR + 5 * UNIT))
#define WG ((bf16_t*)(AR + 2 * UNIT))
#define WL XB
#define WY XB
#define WEW ((bf16_t*)AR)
#define WAA ((bf16_t*)(AR + UNIT))
#define LGATE ((bf16_t*)AR)
#define LXC ((bf16_t*)(AR + UNIT))
#define LAT ((float*)(AR + 2 * UNIT))
#define LINP ((float*)(AR + 4 * UNIT))
#define LXR ((bf16_t*)(AR + 4 * UNIT))
#define LCP ((float2*)(ws + (60ull << 20)))
#define PHASE(...) do { if (ph >= lo && ph < hi) { PTRS __VA_ARGS__; if (ph + 1 < hi) { if (ph == 0) grid.sync(); else grid_barrier(wid_s_, (unsigned*)(ws + BAR_OFF), (volatile LAS unsigned*)(lds + 131072)); } } ++ph; } while (0)
#define FFN_PHASES(s) \
    PHASE({ EpiFfnUp E{(bf16_t*)AR}; GEMM(XB, 1024, W + ((s) ? W_UP1 : W_UP0), 1024, 2 * DFF, 0, E); }); \
    PHASE({ constexpr int PL = layer * 3 + (s) * 2 - 1; EpiResid E{X, PL >= 0 ? X : p->in[I_X], 0.5f, PL >= 0 ? STATS : nullptr, LNG_(PL >= 0 ? PL : 0), LNB_(PL >= 0 ? PL : 0)}; GEMM((bf16_t*)AR, DFF, W + ((s) ? W_DN1 : W_DN0), DFF, 1024, 0, E); }); \
    PHASE({ if constexpr (layer == 2 && (s) == 0) ln_prep_phase(wid_s_, X, WA2, LNG_(6), LNB_(6), STATS); \
            else ln_phase(wid_s_, X, XB, LNG_(layer * 3 + (s) * 2), LNB_(layer * 3 + (s) * 2), STATS, layer * 3 + (s) * 2 == 11); \
            if ((s) == 1 && layer < 3) convert_layer(wid_s_, p, layer + 1, (float*)shm); });
#define SEQ_RET \
        PHASE({ EpiRetQKV E{RQ, RKr, RKt, RVt, CS_}; GEMM(XB, 1024, WX, 1024, 4096, 0, E); }); \
        PHASE({ ret_scan_phase<0>(wid_s_, lds, RQ, RKt, RVt, RSb, RES); ret_s_phase(wid_s_, RQ, RKr, RSb); }); \
        PHASE({ ret_scan_phase<1>(wid_s_, lds, RQ, RKt, RVt, RSb, RES); }); \
        PHASE({ ret_norm_phase(wid_s_, lds, RVt, RQ); }); \
        PHASE({ EpiMulBf E{RQ, 2048, 0, nullptr}; GEMM(XB, 1024, WX + (size_t)4096 * 1024, 1024, 2048, 0, E); });
#define SEQ_S5 \
        PHASE({ EpiF32 E{SU, 1024}; GEMM(XB, 1024, WX, 1024, 1024, 0, E); }); \
        PHASE({ s5_scan_phase<false>(wid_s_, p, lds, SU, SE5, SACT); }); \
        PHASE({ s5_carry_phase(wid_s_, p, SE5); }); \
        PHASE({ s5_scan_phase<true>(wid_s_, p, lds, SU, SE5, SACT); }); \
        PHASE({ EpiMulBf E{SACT, 1024, 1, SZ}; GEMM(SACT, 1024, WX + 1048576, 1024, 1024, 0, E); });
#define SEQ_RW \
        PHASE({ EpiRw1 E{WR, WL}; GEMM(WA2, 2048, WX, 2048, 3328, 0, E); }); \
        PHASE({ EpiRw2 E{WEW, p->in[I_RW_W0], p->in[I_RW_A0]}; GEMM(WL, 256, WX + 6815744, 256, 3072, 0, E); }); \
        PHASE({ rw_scan_phase(wid_s_, p, lds, WR, WK, WV, WEW, WAA, WY); }); \
        PHASE({ rw_post_phase(wid_s_, p, WY, WR, WK, WV, WAA, WG); });
#define SEQ_LRU \
        PHASE({ EpiLruIn E{LGATE, LXR}; GEMM(XB, 1024, WX, 1024, 2048, 0, E); }); \
        PHASE({ lru_conv_phase(wid_s_, p, LXR, LXC); }); \
        PHASE({ EpiLruAx E{(unsigned*)LAT, LXC, p->in[I_LRU_BA], p->in[I_LRU_BX], p->in[I_LRU_LAM]}; GEMM(LXC, 1024, WX + 2097152, 256, 2048, 2, E); }); \
        PHASE({ lru_scan_phase<false>(wid_s_, (const unsigned*)LAT, LCP, LGATE); }); \
        PHASE({ lru_carry_phase(wid_s_, LCP); }); \
        PHASE({ lru_scan_phase<true>(wid_s_, (const unsigned*)LAT, LCP, LGATE); });
#ifndef DUPL
#define DUPL 0
#endif
template <int layer> DEV void run_layer(const int wid_s_, LAS unsigned char* lds, unsigned char* shm, cg::grid_group& grid, int& ph, const int lo, const int hi) {
    FFN_PHASES(0)
    if constexpr (layer == 0) {
        SEQ_RET
        if constexpr ((DUPL & 1) != 0) { SEQ_RET }
        PHASE({ EpiResid E{X, X, 1.0f, STATS, LNG_(layer * 3), LNB_(layer * 3)}; GEMM(RQ, 2048, WX + 6291456, 2048, 1024, 0, E); });
    } else if constexpr (layer == 1) {
        SEQ_S5
        if constexpr ((DUPL & 2) != 0) { SEQ_S5 }
        PHASE({ EpiResid E{X, X, 1.0f, STATS, LNG_(layer * 3), LNB_(layer * 3)}; GEMM(SZ, 1024, WX + 2097152, 1024, 1024, 0, E); });
    } else if constexpr (layer == 2) {
        SEQ_RW
        if constexpr ((DUPL & 4) != 0) { SEQ_RW }
        PHASE({ EpiResid E{X, X, 1.0f, STATS, LNG_(layer * 3), LNB_(layer * 3)}; GEMM(WR, 1024, WX + 7602176, 1024, 1024, 0, E); });
    } else {
        SEQ_LRU
        if constexpr ((DUPL & 8) != 0) { SEQ_LRU }
        PHASE({ EpiResid E{X, X, 1.0f, STATS, LNG_(layer * 3), LNB_(layer * 3)}; GEMM(LGATE, 1024, WX + 2621440, 1024, 1024, 0, E); });
    }
    PHASE({ ln_phase(wid_s_, X, XB, LNG_(layer * 3 + 1), LNB_(layer * 3 + 1), STATS, false); });
    FFN_PHASES(1)
}
__global__ void __launch_bounds__(512) fwd_megakernel(Params p0) {
    extern __shared__ __attribute__((aligned(16))) unsigned char shm[];
    LAS unsigned char* lds = (LAS unsigned char*)shm;
    cg::grid_group grid = cg::this_grid();
    const int wid_s_ = __builtin_amdgcn_readfirstlane((int)(threadIdx.x >> 6));
    int ph = 0; const int lo = p0.ph_lo, hi = p0.ph_hi;
    if (threadIdx.x < 4) ((LAS unsigned*)(lds + 131072))[threadIdx.x] = 0u;
    if (threadIdx.x == 0) (void)xb_add(&((unsigned*)(p0.ws + BAR_OFF))[XB_XCNT(xb_xcc_id())], 1u);
    __syncthreads();
    PHASE({
        const float* xin = p->in[I_X];
        for (long i = (long)obid() * 512 + otid(); i < (long)M_TOK * 256; i += (long)gridDim.x * 512) { const f32x4 v = *(const f32x4*)(xin + i * 4);
            uint2 o; o.x = pack2(v[0], v[1]); o.y = pack2(v[2], v[3]); *(uint2*)(XB + i * 4) = o; }
        for (long i = (long)obid() * 512 + otid(); i < (long)TSEQ * 128; i += (long)gridDim.x * 512) { const int t = (int)(i >> 7), j = (int)(i & 127);
            const double inv = exp2(-(double)j / 128.0 * 13.287712379549449); double sn, cs; sincos((double)t * inv, &sn, &cs); CS_[i] = make_float2((float)cs, (float)sn); }
        s5_build_table(wid_s_, p, (float*)(ws + S5TAB_OFF));
        convert_layer(wid_s_, p, 0, (float*)shm);
    });
    run_layer<0>(wid_s_, lds, shm, grid, ph, lo, hi);
    run_layer<1>(wid_s_, lds, shm, grid, ph, lo, hi);
    run_layer<2>(wid_s_, lds, shm, grid, ph, lo, hi);
    run_layer<3>(wid_s_, lds, shm, grid, ph, lo, hi);
}

constexpr int N_PHASES = 1 + 4 * 6 + 6 + 6 + 6 + 7 + 4;
constexpr int LDS_BYTES = 131072 + 16;

extern "C" void kernel_launch(void* const* d_in, const int* in_sizes, int n_in, void* d_out, int out_size, void* d_ws, size_t ws_size, hipStream_t stream) {
    static int grid = 0;
    if (grid == 0) {
        int dev = 0, cus = 0, per_cu = 0;
        hipGetDevice(&dev); hipDeviceGetAttribute(&cus, hipDeviceAttributeMultiprocessorCount, dev);
        hipFuncSetAttribute((const void*)fwd_megakernel, hipFuncAttributeMaxDynamicSharedMemorySize, LDS_BYTES);
        hipOccupancyMaxActiveBlocksPerMultiprocessor(&per_cu, (const void*)fwd_megakernel, 512, LDS_BYTES);
        if (per_cu < 1) per_cu = 1;
        grid = cus * 1;
        if (n_in != 46 || ws_size < 8 * UNIT) fprintf(stderr, "kernel_launch: unexpected n_in %d / ws_size %zu\n", n_in, ws_size);
    }
    Params p{};
    for (int i = 0; i < 46; ++i) p.in[i] = (const float*)d_in[i];
    p.x = (float*)d_out; p.ws = (unsigned char*)d_ws; p.ph_lo = 0; p.ph_hi = 1000;
    hipMemsetAsync((char*)d_ws + BAR_OFF, 0, 16384, stream);
    void* args[] = {&p};
    hipError_t e = hipLaunchCooperativeKernel((const void*)fwd_megakernel, dim3(grid), dim3(512), args, LDS_BYTES, stream);
    if (e != hipSuccess) fprintf(stderr, "cooperative launch failed: %s (grid %d)\n", hipGetErrorString(e), grid);
}
```

```cpp
#include <hip/hip_runtime.h>
#include <hip/hip_cooperative_groups.h>
#include <cstdio>
namespace cg = cooperative_groups;

#define DEV __device__ __forceinline__
#define LAS __attribute__((address_space(3)))
typedef unsigned short bf16_t;
typedef short bf16x8 __attribute__((ext_vector_type(8)));
typedef float f32x4 __attribute__((ext_vector_type(4)));

constexpr int M_TOK = 32768, DM = 1024, DFF = 2816, TSEQ = 16384;
constexpr float ALPHA = 1.681792830507429f;
constexpr size_t UNIT = 64ull << 20;

DEV float bf2f(bf16_t b) { return __uint_as_float(((unsigned)b) << 16); }
DEV unsigned pack2(float a, float b) { unsigned r; asm("v_cvt_pk_bf16_f32 %0, %1, %2" : "=v"(r) : "v"(a), "v"(b)); return r; }
DEV bf16_t f2bf(float f) { return (bf16_t)pack2(f, f); }
DEV float sigmoidf_(float x) { return __builtin_amdgcn_rcpf(1.0f + __expf(-x)); }
DEV float siluf_(float x) { return x * __builtin_amdgcn_rcpf(1.0f + __expf(-x)); }
DEV float tanhf_(float x) { float e = __expf(-2.0f * fabsf(x)); float t = (1.0f - e) * __builtin_amdgcn_rcpf(1.0f + e); return x < 0.f ? -t : t; }
DEV float geluf_(float x) { return 0.5f * x * (1.0f + tanhf_(0.7978845608028654f * (x + 0.044715f * x * x * x))); }
DEV float softplus_neg(float l) { const float x = __expf(-l); return x < 0.03f ? x * (1.0f - x * (0.5f - x * (0.33333333f - 0.25f * x))) : (l < -15.f ? -l : __logf(1.0f + x)); }
DEV float neg_expm1(float y) { return y > -0.05f ? -y * (1.0f + y * (0.5f + y * (0.16666667f + y * 0.041666667f))) : 1.0f - __expf(y); }
DEV float wave_sum(float v) { for (int o = 32; o > 0; o >>= 1) v += __shfl_xor(v, o, 64); return v; }
template <int CTRL> DEV float dppf(float v) { return __int_as_float(__builtin_amdgcn_update_dpp(0, __float_as_int(v), CTRL, 0xF, 0xF, true)); }
DEV int otid_(int wv) { int t = wv * 64 + (int)__builtin_amdgcn_mbcnt_hi(~0u, __builtin_amdgcn_mbcnt_lo(~0u, 0u)); asm volatile("" : "+v"(t)); return t; }
#define otid() otid_(wid_s_)
DEV int obid() { int t = blockIdx.x; asm volatile("" : "+s"(t)); return t; }
DEV float sum16(float v) { v += dppf<0xB1>(v); v += dppf<0x4E>(v); v += dppf<0x141>(v); v += dppf<0x140>(v); return v; }
DEV float rdlane(float v, int l) { return __int_as_float(__builtin_amdgcn_readlane(__float_as_int(v), l)); }
DEV float wave_sum_fast(float v) { v = sum16(v); return (rdlane(v, 0) + rdlane(v, 16)) + (rdlane(v, 32) + rdlane(v, 48)); }

struct Params {
    const float* in[46];
    float* x;
    unsigned char* ws;
    int ph_lo, ph_hi;
};
typedef const __attribute__((address_space(4))) Params* CP;
enum { I_X, I_LNG, I_LNB, I_W1, I_W3, I_W2, I_RET_IN, I_RET_OUT, I_S5_IN, I_S5_ARE, I_S5_AIM, I_S5_BRE, I_S5_BIM, I_S5_CRE, I_S5_CIM, I_S5_D, I_S5_LS, I_S5_GLU, I_S5_OUT,
       I_RW_MU, I_RW_R, I_RW_K, I_RW_V, I_RW_W0, I_RW_W1, I_RW_W2, I_RW_A0, I_RW_A1, I_RW_A2, I_RW_G1, I_RW_G2, I_RW_KK, I_RW_KA, I_RW_RK, I_RW_LG, I_RW_LB, I_RW_O,
       I_LRU_IN, I_LRU_CW, I_LRU_CB, I_LRU_WA, I_LRU_BA, I_LRU_WX, I_LRU_BX, I_LRU_LAM, I_LRU_OUT };

namespace pg8 {
constexpr int BM = 256, BK = 64, HALF = 128, HTB = HALF * BK * 2, STAGE_BYTES = 8 * HTB, NXCD = 8, WGM = 8;
DEV int lds_byte(int r, int c) { const int st = (r >> 4) * 2 + (c >> 5), rr = r & 15, cc = c & 31, ob = rr * 64 + cc * 2; return st * 1024 + (ob ^ (((ob >> 9) & 1) << 5)); }
DEV void stage_rc(int b, int& R, int& C) { const int st = b / 1024, sb = b % 1024, swz = sb ^ (((sb >> 9) & 1) << 5); R = (st >> 1) * 16 + swz / 64; C = (st & 1) * 32 + (swz % 64) / 2; }
struct Unit { int pm, pn; };
struct Gemm { const bf16_t* A; const bf16_t* Bt; int lda, K, nM, nN, a_grp; };
struct StaticOrder {
    int nM, nN, nwg, G, c;
    DEV void init(int nM_, int nN_, int G_, int c_) { nM = nM_; nN = nN_; nwg = nM * nN; G = G_; c = c_; }
    DEV bool next(int i, Unit& u) const {
        const long L = (long)i * G + c; if (L >= nwg) return false;
        int wgid = (int)L; { const int q = nwg / NXCD, r = nwg % NXCD, xcd = wgid % NXCD, off = wgid / NXCD; wgid = (xcd < r ? xcd * (q + 1) : r * (q + 1) + (xcd - r) * q) + off; }
        const int nig = WGM * nN, gid = wgid / nig, fm = gid * WGM, gsz = (nM - fm) < WGM ? (nM - fm) : WGM;
        u.pm = fm + ((wgid % nig) % gsz); u.pn = (wgid % nig) / gsz; return true;
    }
};
template <class Epi>
DEV void gemm_phase(const int wid_s_, LAS unsigned char* lds, const Gemm g, const Epi& E) {
    StaticOrder S; S.init(g.nM, g.nN, (int)gridDim.x, obid());
    const int tid = otid(), wid = __builtin_amdgcn_readfirstlane(tid >> 6), lane = tid & 63, wr = wid >> 2, wc = wid & 3, fr = lane & 15, fq = lane >> 4;
    const int K = g.K, nt = K / BK, lda = g.lda;
    unsigned voffA[2], voffB[2];
#pragma unroll
    for (int i = 0; i < 2; ++i) { int R, C; stage_rc(tid * 16 + i * 8192, R, C); voffA[i] = (unsigned)(R * lda + C) * 2u; voffB[i] = (unsigned)(R * K + C) * 2u; }
    const size_t kstep = (size_t)(BK * 2);
    const size_t hstepA = (size_t)HALF * lda * 2, hstepB = (size_t)HALF * K * 2;
    const size_t tstepA = 2 * hstepA, tstepB = 2 * hstepB;
    const unsigned ldsw = (unsigned)wid * 1024u;
    const int aoff = lds_byte(wr * 64 + fr, fq * 8), boff = lds_byte(wc * 32 + fr, fq * 8);
#define PG8_SA(b, h) (((b) * 2 + (h)) * HTB)
#define PG8_SB(b, h) ((4 + (b) * 2 + (h)) * HTB)
#define PG8_STAGE(bufoff, gbase, voff) do { _Pragma("unroll") for (int _i = 0; _i < 2; ++_i) \
        __builtin_amdgcn_global_load_lds((const unsigned*)((const char*)(gbase) + (voff)[_i]), (LAS unsigned*)(lds + (bufoff) + ldsw + _i * 8192), 16, 0, 0); } while (0)
#define PG8_LDA(dst, b, h) do { _Pragma("unroll") for (int m = 0; m < 4; ++m) _Pragma("unroll") for (int k = 0; k < 2; ++k) dst[m][k] = *(const LAS bf16x8*)(lds + PG8_SA(b, h) + aoff + m * 2048 + k * 1024); } while (0)
#define PG8_LDB(dst, b, h) do { _Pragma("unroll") for (int n = 0; n < 2; ++n) _Pragma("unroll") for (int k = 0; k < 2; ++k) dst[n][k] = *(const LAS bf16x8*)(lds + PG8_SB(b, h) + boff + n * 2048 + k * 1024); } while (0)
#define PG8_MMA(ai, bj, At, Bt) do { __builtin_amdgcn_s_setprio(1); _Pragma("unroll") for (int m = 0; m < 4; ++m) _Pragma("unroll") for (int n = 0; n < 2; ++n) _Pragma("unroll") for (int k = 0; k < 2; ++k) \
        acc[ai][bj][m][n] = __builtin_amdgcn_mfma_f32_16x16x32_bf16(Bt[n][k], At[m][k], acc[ai][bj][m][n], 0, 0, 0); __builtin_amdgcn_s_setprio(0); } while (0)
#define PG8_WAIT_V(n) asm volatile("s_waitcnt vmcnt(" #n ")" ::: "memory")
#define PG8_WAIT_L(n) asm volatile("s_waitcnt lgkmcnt(" #n ")" ::: "memory")
#define PG8_BAR __builtin_amdgcn_s_barrier()
#define PG8_SCHED __builtin_amdgcn_sched_barrier(0)
#define PG8_UA(u) ((const char*)g.A + (size_t)(u).pm * tstepA + (g.a_grp ? (size_t)((u).pn / g.a_grp) * (size_t)K * 2 : (size_t)0))
#define PG8_UB(u) ((const char*)g.Bt + (size_t)(u).pn * tstepB)
    Unit cur, nxt; int ui = 0;
    if (!S.next(0, cur)) return;
    f32x4 acc[2][2][4][2];
#pragma unroll
    for (int a = 0; a < 2; ++a)
#pragma unroll
        for (int b = 0; b < 2; ++b)
#pragma unroll
            for (int m = 0; m < 4; ++m)
#pragma unroll
                for (int n = 0; n < 2; ++n) acc[a][b][m][n] = (f32x4){0.f, 0.f, 0.f, 0.f};
    bf16x8 At[4][2], B0[2][2], B1[2][2];
    const char* cA = PG8_UA(cur); const char* cB = PG8_UB(cur);
    PG8_STAGE(PG8_SB(0, 0), cB, voffB); PG8_STAGE(PG8_SA(0, 0), cA, voffA); PG8_STAGE(PG8_SB(0, 1), cB + hstepB, voffB); PG8_STAGE(PG8_SA(0, 1), cA + hstepA, voffA);
    if (wr == 1) PG8_BAR;
    PG8_WAIT_V(4); PG8_BAR;
    PG8_STAGE(PG8_SB(1, 0), cB + kstep, voffB); PG8_STAGE(PG8_SA(1, 0), cA + kstep, voffA); PG8_STAGE(PG8_SB(1, 1), cB + hstepB + kstep, voffB);
    PG8_WAIT_V(6); PG8_BAR;
    for (;;) {
        const bool has_next = S.next(ui + 1, nxt);
        const char* nA = has_next ? PG8_UA(nxt) : cA; const char* nB = has_next ? PG8_UB(nxt) : cB;
        for (int t = 0; t < nt; t += 2) {
            const bool last = (t == nt - 2);
            const char* a1 = cA + (size_t)(t + 1) * kstep;
            const char* a2 = last ? nA : cA + (size_t)(t + 2) * kstep; const char* b2 = last ? nB : cB + (size_t)(t + 2) * kstep;
            const char* a3 = a2 + kstep; const char* b3 = b2 + kstep;
            PG8_LDB(B0, 0, 0); PG8_SCHED; PG8_LDA(At, 0, 0); PG8_STAGE(PG8_SA(1, 1), a1 + hstepA, voffA);
            PG8_WAIT_L(8); PG8_BAR; PG8_WAIT_L(0); PG8_MMA(0, 0, At, B0); PG8_BAR; PG8_SCHED;
            PG8_LDB(B1, 0, 1); PG8_STAGE(PG8_SB(0, 0), b2, voffB);
            PG8_BAR; PG8_WAIT_L(0); PG8_MMA(0, 1, At, B1); PG8_BAR;
            PG8_LDA(At, 0, 1); PG8_STAGE(PG8_SA(0, 0), a2, voffA);
            PG8_BAR; PG8_WAIT_L(0); PG8_MMA(1, 0, At, B0); PG8_BAR; PG8_SCHED;
            PG8_STAGE(PG8_SB(0, 1), b2 + hstepB, voffB);
            PG8_WAIT_V(6); PG8_BAR; PG8_MMA(1, 1, At, B1); PG8_BAR;
            PG8_LDB(B0, 1, 0); PG8_SCHED; PG8_LDA(At, 1, 0); PG8_STAGE(PG8_SA(0, 1), a2 + hstepA, voffA);
            PG8_WAIT_L(8); PG8_BAR; PG8_WAIT_L(0); PG8_MMA(0, 0, At, B0); PG8_BAR; PG8_SCHED;
            PG8_LDB(B1, 1, 1); PG8_STAGE(PG8_SB(1, 0), b3, voffB);
            PG8_BAR; PG8_WAIT_L(0); PG8_MMA(0, 1, At, B1); PG8_BAR;
            PG8_LDA(At, 1, 1); PG8_STAGE(PG8_SA(1, 0), a3, voffA);
            PG8_BAR; PG8_WAIT_L(0); PG8_MMA(1, 0, At, B0); PG8_BAR; PG8_SCHED;
            PG8_STAGE(PG8_SB(1, 1), b3 + hstepB, voffB);
            PG8_WAIT_V(6); PG8_BAR; PG8_MMA(1, 1, At, B1); PG8_BAR;
        }
        E(acc, cur, wr, wc, fr, fq);
        if (!has_next) break;
#pragma unroll
        for (int a = 0; a < 2; ++a)
#pragma unroll
            for (int b = 0; b < 2; ++b)
#pragma unroll
                for (int m = 0; m < 4; ++m)
#pragma unroll
                    for (int n = 0; n < 2; ++n) acc[a][b][m][n] = (f32x4){0.f, 0.f, 0.f, 0.f};
        cur = nxt; cA = nA; cB = nB; ++ui;
    }
    PG8_WAIT_V(0);
    if (wr == 0) PG8_BAR;
    PG8_BAR;
#undef PG8_SA
#undef PG8_SB
#undef PG8_STAGE
#undef PG8_LDA
#undef PG8_LDB
#undef PG8_MMA
#undef PG8_UA
#undef PG8_UB
}
}
using pg8::Unit;
typedef const f32x4 (&AccRef)[2][2][4][2];
#define EPI_ROWS _Pragma("unroll") for (int ai = 0; ai < 2; ++ai) _Pragma("unroll") for (int m = 0; m < 4; ++m) if ((__builtin_amdgcn_sched_barrier(0), true))
#define EPI_ROW (u.pm * 256 + ai * 128 + wr * 64 + m * 16 + fr)
#define EPI_COLS _Pragma("unroll") for (int bj = 0; bj < 2; ++bj) _Pragma("unroll") for (int n = 0; n < 2; ++n)
#define EPI_CC (bj * 128 + wc * 32 + n * 16 + fq * 4)

struct EpiFfnUp { bf16_t* H;
    DEV void operator()(AccRef acc, const Unit& u, int wr, int wc, int fr, int fq) const {
        EPI_ROWS { const int row = EPI_ROW;
#pragma unroll
            for (int bj = 0; bj < 2; ++bj) { const int col = (u.pn * 8 + bj * 4 + wc) * 16 + fq * 4; const f32x4 a = acc[ai][bj][m][0], b = acc[ai][bj][m][1];
                uint2 o; o.x = pack2(siluf_(a[0]) * b[0], siluf_(a[1]) * b[1]); o.y = pack2(siluf_(a[2]) * b[2], siluf_(a[3]) * b[3]);
                *(uint2*)(H + (size_t)row * DFF + col) = o; } }
    } };
struct EpiResid { float* X; const float* XS; float s; const float2* st; const float* g; const float* b;
    DEV void operator()(AccRef acc, const Unit& u, int wr, int wc, int fr, int fq) const {
        const int row0 = u.pm * 256 + wr * 64 + fr;
        float mu[8], rs[8];
#pragma unroll
        for (int r = 0; r < 8; ++r) { mu[r] = 0.f; rs[r] = 1.f; if (st) { const float2 t = st[row0 + (r >> 2) * 128 + (r & 3) * 16]; mu[r] = t.x; rs[r] = t.y; } }
#pragma unroll
        for (int bj = 0; bj < 2; ++bj)
#pragma unroll
            for (int n = 0; n < 2; ++n) { __builtin_amdgcn_sched_barrier(0);
                const int col = u.pn * 256 + EPI_CC; f32x4 gv = {1.f, 1.f, 1.f, 1.f}, bv = {0.f, 0.f, 0.f, 0.f};
                if (st) { gv = *(const f32x4*)(g + col); bv = *(const f32x4*)(b + col); }
#pragma unroll
                for (int r = 0; r < 8; ++r) { const int ai = r >> 2, m = r & 3; const size_t eo = (size_t)(row0 + ai * 128 + m * 16) * DM + col; f32x4* p = (f32x4*)(X + eo); f32x4 v = *(const f32x4*)(XS + eo);
                    if (st) v = (v - mu[r]) * rs[r] * gv + bv;
                    *p = v * ALPHA + acc[ai][bj][m][n] * s; } }
    } };
struct EpiF32 { float* C; int ldc;
    DEV void operator()(AccRef acc, const Unit& u, int wr, int wc, int fr, int fq) const {
        EPI_ROWS { float* rp = C + (size_t)EPI_ROW * ldc + u.pn * 256;
            EPI_COLS { *(f32x4*)(rp + EPI_CC) = acc[ai][bj][m][n]; } }
    } };
struct EpiRetQKV { bf16_t *Q, *Kr, *Kt, *Vt; const float2* cs;
    DEV void operator()(AccRef acc, const Unit& u, int wr, int wc, int fr, int fq) const {
        const int pn = u.pn;
        if (pn < 8) {
            const int h = pn & 3; const bool isk = pn >= 4;
            const float lg2 = log2f(1.0f - exp2f(-5.0f - (float)h));
            EPI_ROWS { const int row = EPI_ROW, t = row & (TSEQ - 1), b = row >> 14;
                const float kdec = exp2f((float)(127 - (t & 127)) * lg2) * 0.0625f;
#pragma unroll
                for (int n = 0; n < 2; ++n) { const int j = wc * 32 + n * 16 + fq * 4; float o1[4], o2[4];
#pragma unroll
                    for (int i = 0; i < 4; ++i) { const float2 c = cs[(size_t)t * 128 + j + i]; const float t1 = acc[ai][0][m][n][i], t2 = acc[ai][1][m][n][i]; o1[i] = t1 * c.x - t2 * c.y; o2[i] = t1 * c.y + t2 * c.x; }
                    if (!isk) { bf16_t* p = Q + (size_t)row * 1024 + h * 256 + j; uint2 a, bb; a.x = pack2(o1[0], o1[1]); a.y = pack2(o1[2], o1[3]); bb.x = pack2(o2[0], o2[1]); bb.y = pack2(o2[2], o2[3]);
                        *(uint2*)p = a; *(uint2*)(p + 128) = bb; }
                    else { bf16_t* p = Kr + (size_t)row * 1024 + h * 256 + j; uint2 a, bb; a.x = pack2(o1[0] * 0.0625f, o1[1] * 0.0625f); a.y = pack2(o1[2] * 0.0625f, o1[3] * 0.0625f);
                        bb.x = pack2(o2[0] * 0.0625f, o2[1] * 0.0625f); bb.y = pack2(o2[2] * 0.0625f, o2[3] * 0.0625f); *(uint2*)p = a; *(uint2*)(p + 128) = bb;
                        bf16_t* pt = Kt + ((size_t)(((b * 4 + h) * 128 + (t >> 7)) * 256 + j)) * 128 + (t & 127);
#pragma unroll
                        for (int i = 0; i < 4; ++i) { pt[i * 128] = f2bf(o1[i] * kdec); pt[(i + 128) * 128] = f2bf(o2[i] * kdec); } } } }
        } else {
            const int h = (pn - 8) >> 1, eb = ((pn - 8) & 1) * 256;
            EPI_ROWS { const int row = EPI_ROW, t = row & (TSEQ - 1), b = row >> 14;
                EPI_COLS { const int e = eb + EPI_CC; bf16_t* pt = Vt + ((size_t)(((b * 4 + h) * 128 + (t >> 7)) * 512 + e)) * 128 + (t & 127);
#pragma unroll
                    for (int i = 0; i < 4; ++i) pt[i * 128] = f2bf(acc[ai][bj][m][n][i]); } }
        }
    } };
struct EpiMulBf { bf16_t* O; int ldo; int mode;
    bf16_t* O2;
    DEV void operator()(AccRef acc, const Unit& u, int wr, int wc, int fr, int fq) const {
        EPI_ROWS { const size_t ro = (size_t)EPI_ROW * ldo + u.pn * 256;
            EPI_COLS { const uint2 v = *(const uint2*)(O + ro + EPI_CC); const f32x4 a = acc[ai][bj][m][n]; float f[4] = {bf2f((bf16_t)(v.x & 0xffff)), bf2f((bf16_t)(v.x >> 16)), bf2f((bf16_t)(v.y & 0xffff)), bf2f((bf16_t)(v.y >> 16))};
                float r[4];
#pragma unroll
                for (int i = 0; i < 4; ++i) r[i] = mode == 0 ? siluf_(a[i]) * f[i] : f[i] * sigmoidf_(a[i]);
                uint2 o; o.x = pack2(r[0], r[1]); o.y = pack2(r[2], r[3]); *(uint2*)((mode == 0 ? O : O2) + ro + EPI_CC) = o; } }
    } };
struct EpiRw1 { bf16_t *R, *L;
    DEV void operator()(AccRef acc, const Unit& u, int wr, int wc, int fr, int fq) const {
        const int pn = u.pn;
        EPI_ROWS { const int row = EPI_ROW;
            EPI_COLS { const int cc = EPI_CC; f32x4 a = acc[ai][bj][m][n]; uint2 o;
                if (pn < 12) { bf16_t* dst = R + (size_t)(pn >> 2) * (UNIT / 2); o.x = pack2(a[0], a[1]); o.y = pack2(a[2], a[3]); *(uint2*)(dst + (size_t)row * 1024 + (pn & 3) * 256 + cc) = o; }
                else { float r[4];
#pragma unroll
                    for (int i = 0; i < 4; ++i) r[i] = bj == 1 ? sigmoidf_(a[i]) : (wc < 2 ? tanhf_(a[i]) : a[i]);
                    o.x = pack2(r[0], r[1]); o.y = pack2(r[2], r[3]); *(uint2*)(L + (size_t)row * 256 + cc) = o; } } }
    } };
struct EpiRw2 { bf16_t *EW; const float *w0, *a0;
    DEV void operator()(AccRef acc, const Unit& u, int wr, int wc, int fr, int fq) const {
        const int pn = u.pn;
        EPI_ROWS { const int row = EPI_ROW;
            EPI_COLS { __builtin_amdgcn_sched_barrier(0); const int c = (pn & 3) * 256 + EPI_CC; f32x4 a = acc[ai][bj][m][n]; float r[4];
                if (pn < 4) { const f32x4 w = *(const f32x4*)(w0 + c);
#pragma unroll
                    for (int i = 0; i < 4; ++i) r[i] = 0.6065306597126334f * sigmoidf_(w[i] + a[i]); }
                else if (pn < 8) { const f32x4 w = *(const f32x4*)(a0 + c);
#pragma unroll
                    for (int i = 0; i < 4; ++i) r[i] = sigmoidf_(w[i] + a[i]); }
                else {
#pragma unroll
                    for (int i = 0; i < 4; ++i) r[i] = a[i]; }
                uint2 o; o.x = pack2(r[0], r[1]); o.y = pack2(r[2], r[3]); *(uint2*)(EW + (size_t)(pn >> 2) * (UNIT / 2) + (size_t)row * 1024 + c) = o; } }
    } };
struct EpiLruIn { bf16_t *GATE, *XR;
    DEV void operator()(AccRef acc, const Unit& u, int wr, int wc, int fr, int fq) const {
        const int pn = u.pn;
        EPI_ROWS { const int row = EPI_ROW;
            EPI_COLS { const int c = (pn & 3) * 256 + EPI_CC; f32x4 a = acc[ai][bj][m][n]; uint2 o;
                if (pn < 4) { o.x = pack2(geluf_(a[0]), geluf_(a[1])); o.y = pack2(geluf_(a[2]), geluf_(a[3])); *(uint2*)(GATE + (size_t)row * 1024 + c) = o; }
                else { o.x = pack2(a[0], a[1]); o.y = pack2(a[2], a[3]); *(uint2*)(XR + (size_t)row * 1024 + c) = o; } } }
    } };
struct EpiLruAx { unsigned* PK; const bf16_t* XC; const float *ba, *bx, *lam;
    DEV void operator()(AccRef acc, const Unit& u, int wr, int wc, int fr, int fq) const {
        const int pn = u.pn;
        EPI_ROWS { const int row = EPI_ROW;
#pragma unroll
            for (int bj = 0; bj < 2; ++bj) { __builtin_amdgcn_sched_barrier(0); const int ch = (pn >> 1) * 256 + ((pn & 1) * 8 + bj * 4 + wc) * 16 + fq * 4;
                const f32x4 ga = acc[ai][bj][m][0], gx = acc[ai][bj][m][1]; const f32x4 vba = *(const f32x4*)(ba + ch), vbx = *(const f32x4*)(bx + ch), vl = *(const f32x4*)(lam + ch);
                const uint2 xv = *(const uint2*)(XC + (size_t)row * 1024 + ch); const float xf[4] = {bf2f((bf16_t)(xv.x & 0xffff)), bf2f((bf16_t)(xv.x >> 16)), bf2f((bf16_t)(xv.y & 0xffff)), bf2f((bf16_t)(xv.y >> 16))};
                unsigned ow[4];
#pragma unroll
                for (int i = 0; i < 4; ++i) { const float r = sigmoidf_(ga[i] + vba[i]), it = sigmoidf_(gx[i] + vbx[i]);
                    const float la = -8.0f * r * softplus_neg(vl[i]); ow[i] = pack2(neg_expm1(la), sqrtf(neg_expm1(2.0f * la)) * (it * xf[i])); }
                *(uint4*)(PK + (size_t)row * 1024 + ch) = make_uint4(ow[0], ow[1], ow[2], ow[3]); } }
    } };

DEV void cvt_t(const int wid_s_, float* lf, bf16_t* dst, int dld, int dn0, int dk0, const float* src, int sld, int sc0, int N, int K, const float* ks, int perm) {
    const int tn = N >> 6, tiles = tn * (K >> 6), tid = otid();
    for (int tile = obid(); tile < tiles; tile += gridDim.x) {
        const int n0 = (tile % tn) * 64, k0 = (tile / tn) * 64;
#pragma unroll
        for (int i = 0; i < 8; ++i) { const int kk = (tid >> 6) + 8 * i, nn = tid & 63; float v = src[(size_t)(k0 + kk) * sld + sc0 + n0 + nn]; if (ks) v *= ks[k0 + kk]; lf[kk * 65 + nn] = v; }
        __syncthreads();
#pragma unroll
        for (int i = 0; i < 8; ++i) { const int nn = (tid >> 6) + 8 * i, kk = tid & 63, n = n0 + nn; const int pn = perm < 0 ? n : ((n >> 4) * 32 + perm * 16 + (n & 15));
            dst[(size_t)(dn0 + pn) * dld + dk0 + k0 + kk] = f2bf(lf[kk * 65 + nn]); }
        __syncthreads();
    }
}
DEV void fill0(const int wid_s_, bf16_t* dst, int dld, int n0, int k0, int N, int K) {
    const int per = K >> 3; const long tot = (long)N * per;
    for (long i = (long)obid() * blockDim.x + otid(); i < tot; i += (long)gridDim.x * blockDim.x) { const int n = (int)(i / per), k = (int)(i % per) * 8; *(uint4*)(dst + (size_t)(n0 + n) * dld + k0 + k) = make_uint4(0, 0, 0, 0); }
}
constexpr size_t W_UP0 = 0, W_DN0 = 5767168, W_UP1 = 8650752, W_DN1 = 14417920, W_MIX = 17301504;
DEV void convert_layer(const int wid_s_, CP p, int layer, float* lf) {
    bf16_t* W = (bf16_t*)p->ws;
    for (int s = 0; s < 2; ++s) { const size_t wo = (size_t)(layer * 2 + s) * 1024 * DFF;
        cvt_t(wid_s_, lf, W + (s ? W_UP1 : W_UP0), 1024, 0, 0, p->in[I_W1] + wo, DFF, 0, DFF, 1024, nullptr, 0);
        cvt_t(wid_s_, lf, W + (s ? W_UP1 : W_UP0), 1024, 0, 0, p->in[I_W3] + wo, DFF, 0, DFF, 1024, nullptr, 1);
        cvt_t(wid_s_, lf, W + (s ? W_DN1 : W_DN0), DFF, 0, 0, p->in[I_W2] + wo, 1024, 0, 1024, DFF, nullptr, -1); }
    bf16_t* X = W + W_MIX;
    if (layer == 0) { cvt_t(wid_s_, lf, X, 1024, 0, 0, p->in[I_RET_IN], 6144, 0, 6144, 1024, nullptr, -1); cvt_t(wid_s_, lf, X + 6291456, 2048, 0, 0, p->in[I_RET_OUT], 1024, 0, 1024, 2048, nullptr, -1); }
    else if (layer == 1) { cvt_t(wid_s_, lf, X, 1024, 0, 0, p->in[I_S5_IN], 1024, 0, 1024, 1024, nullptr, -1); cvt_t(wid_s_, lf, X + 1048576, 1024, 0, 0, p->in[I_S5_GLU], 1024, 0, 1024, 1024, nullptr, -1);
        cvt_t(wid_s_, lf, X + 2097152, 1024, 0, 0, p->in[I_S5_OUT], 1024, 0, 1024, 1024, nullptr, -1); }
    else if (layer == 2) { const float* mu = p->in[I_RW_MU];
        const float* srcs[6] = {p->in[I_RW_R], p->in[I_RW_K], p->in[I_RW_V], p->in[I_RW_W1], p->in[I_RW_A1], p->in[I_RW_G1]};
        const int mus[6] = {0, 2, 3, 1, 4, 5}, n0s[6] = {0, 1024, 2048, 3072, 3136, 3200}, ns[6] = {1024, 1024, 1024, 64, 64, 128};
#pragma unroll
        for (int q = 0; q < 6; ++q) { cvt_t(wid_s_, lf, X, 2048, n0s[q], 0, srcs[q], ns[q], 0, ns[q], 1024, nullptr, -1); cvt_t(wid_s_, lf, X + 0, 2048, n0s[q], 1024, srcs[q], ns[q], 0, ns[q], 1024, mu + mus[q] * 1024, -1); }
        bf16_t* X2 = X + 6815744;
        cvt_t(wid_s_, lf, X2, 256, 0, 0, p->in[I_RW_W2], 1024, 0, 1024, 64, nullptr, -1); cvt_t(wid_s_, lf, X2, 256, 1024, 64, p->in[I_RW_A2], 1024, 0, 1024, 64, nullptr, -1); cvt_t(wid_s_, lf, X2, 256, 2048, 128, p->in[I_RW_G2], 1024, 0, 1024, 128, nullptr, -1);
        fill0(wid_s_, X2, 256, 0, 64, 1024, 192); fill0(wid_s_, X2, 256, 1024, 0, 1024, 64); fill0(wid_s_, X2, 256, 1024, 128, 1024, 128); fill0(wid_s_, X2, 256, 2048, 0, 1024, 128);
        cvt_t(wid_s_, lf, X + 7602176, 1024, 0, 0, p->in[I_RW_O], 1024, 0, 1024, 1024, nullptr, -1); }
    else { cvt_t(wid_s_, lf, X, 1024, 0, 0, p->in[I_LRU_IN], 2048, 0, 2048, 1024, nullptr, -1);
        for (int blk = 0; blk < 4; ++blk) { cvt_t(wid_s_, lf, X + 2097152, 256, blk * 512, 0, p->in[I_LRU_WA] + blk * 65536, 256, 0, 256, 256, nullptr, 0); cvt_t(wid_s_, lf, X + 2097152, 256, blk * 512, 0, p->in[I_LRU_WX] + blk * 65536, 256, 0, 256, 256, nullptr, 1); }
        cvt_t(wid_s_, lf, X + 2621440, 1024, 0, 0, p->in[I_LRU_OUT], 1024, 0, 1024, 1024, nullptr, -1); }
}

DEV void ln_phase(const int wid_s_, float* X, bf16_t* XB, const float* g, const float* b, float2* st, const bool write_x) {
    const int lane = otid() & 63, wv = otid() >> 6;
    f32x4 gv[4], bv[4];
#pragma unroll
    for (int j = 0; j < 4; ++j) { gv[j] = *(const f32x4*)(g + j * 256 + lane * 4); bv[j] = *(const f32x4*)(b + j * 256 + lane * 4); }
    for (int row = obid() * 8 + wv; row < M_TOK; row += gridDim.x * 8) {
        float* rp = X + (size_t)row * DM; f32x4 v[4]; float s = 0.f;
#pragma unroll
        for (int j = 0; j < 4; ++j) { v[j] = *(const f32x4*)(rp + j * 256 + lane * 4); s += v[j][0] + v[j][1] + v[j][2] + v[j][3]; }
        const float mu = wave_sum_fast(s) * (1.0f / DM); float q = 0.f;
#pragma unroll
        for (int j = 0; j < 4; ++j) { v[j] = v[j] - mu; q += v[j][0] * v[j][0] + v[j][1] * v[j][1] + v[j][2] * v[j][2] + v[j][3] * v[j][3]; }
        const float rs = rsqrtf(wave_sum_fast(q) * (1.0f / DM) + 1e-5f);
        if (lane == 0) st[row] = make_float2(mu, rs);
#pragma unroll
        for (int j = 0; j < 4; ++j) { f32x4 o = v[j] * rs * gv[j] + bv[j]; if (write_x) *(f32x4*)(rp + j * 256 + lane * 4) = o;
            uint2 pk; pk.x = pack2(o[0], o[1]); pk.y = pack2(o[2], o[3]); *(uint2*)(XB + (size_t)row * DM + j * 256 + lane * 4) = pk; }
    }
}

DEV void ln_prep_phase(const int wid_s_, const float* X, bf16_t* A2, const float* g, const float* b, float2* st) {
    const int lane = otid() & 63, wv = otid() >> 6;
    f32x4 gv[4], bv[4];
#pragma unroll
    for (int j = 0; j < 4; ++j) { gv[j] = *(const f32x4*)(g + j * 256 + lane * 4); bv[j] = *(const f32x4*)(b + j * 256 + lane * 4); }
    for (int r0 = (obid() * 8 + wv) * 16; r0 < M_TOK; r0 += gridDim.x * 8 * 16) {
        f32x4 prev[4], cur[4], nxt[4];
        const bool has_prev = (r0 & (TSEQ - 1)) != 0; const int first = has_prev ? r0 - 1 : r0;
#pragma unroll
        for (int j = 0; j < 4; ++j) { nxt[j] = *(const f32x4*)(X + (size_t)first * DM + j * 256 + lane * 4); prev[j] = (f32x4){0.f, 0.f, 0.f, 0.f}; }
        for (int row = first; row < r0 + 16; ++row) {
#pragma unroll
            for (int j = 0; j < 4; ++j) cur[j] = nxt[j];
            if (row + 1 < r0 + 16) {
#pragma unroll
                for (int j = 0; j < 4; ++j) nxt[j] = *(const f32x4*)(X + (size_t)(row + 1) * DM + j * 256 + lane * 4); }
            float s = 0.f;
#pragma unroll
            for (int j = 0; j < 4; ++j) s += cur[j][0] + cur[j][1] + cur[j][2] + cur[j][3];
            const float mu = wave_sum_fast(s) * (1.0f / DM); float q = 0.f;
#pragma unroll
            for (int j = 0; j < 4; ++j) { cur[j] = cur[j] - mu; q += cur[j][0] * cur[j][0] + cur[j][1] * cur[j][1] + cur[j][2] * cur[j][2] + cur[j][3] * cur[j][3]; }
            const float rs = rsqrtf(wave_sum_fast(q) * (1.0f / DM) + 1e-5f);
#pragma unroll
            for (int j = 0; j < 4; ++j) cur[j] = cur[j] * rs * gv[j] + bv[j];
            if (row >= r0) {
                if (lane == 0) st[row] = make_float2(mu, rs);
#pragma unroll
                for (int j = 0; j < 4; ++j) { uint2 o; o.x = pack2(cur[j][0], cur[j][1]); o.y = pack2(cur[j][2], cur[j][3]); *(uint2*)(A2 + (size_t)row * 2048 + j * 256 + lane * 4) = o;
                    const f32x4 d = prev[j] - cur[j]; o.x = pack2(d[0], d[1]); o.y = pack2(d[2], d[3]); *(uint2*)(A2 + (size_t)row * 2048 + 1024 + j * 256 + lane * 4) = o; } }
#pragma unroll
            for (int j = 0; j < 4; ++j) prev[j] = cur[j];
        }
    }
}

DEV void ret_s_phase(const int wid_s_, const bf16_t* Q, const bf16_t* Kr, bf16_t* Sb) {
    const int lane = otid() & 63, w = otid() >> 6, fr = lane & 15, fq = lane >> 4;
    for (int item = obid(); item < 1024; item += gridDim.x) {
        const int h = item & 3, c = (item >> 2) & 127, b = item >> 9; const size_t rowbase = (size_t)b * TSEQ + c * 128;
        const float lg2 = log2f(1.0f - exp2f(-5.0f - (float)h));
        bf16x8 yq[8];
#pragma unroll
        for (int ks = 0; ks < 8; ++ks) yq[ks] = *(const bf16x8*)(Q + (rowbase + 16 * w + fr) * 1024 + h * 256 + ks * 32 + fq * 8);
        bf16_t* So = Sb + (size_t)item * 16384;
        const int ii = 16 * w + fr;
        for (int jt = 0; jt <= w; ++jt) {
            f32x4 acc = {0.f, 0.f, 0.f, 0.f};
#pragma unroll
            for (int ks = 0; ks < 8; ++ks) { const bf16x8 xk = *(const bf16x8*)(Kr + (rowbase + 16 * jt + fr) * 1024 + h * 256 + ks * 32 + fq * 8); acc = __builtin_amdgcn_mfma_f32_16x16x32_bf16(xk, yq[ks], acc, 0, 0, 0); }
            float r[4];
#pragma unroll
            for (int i = 0; i < 4; ++i) { const int jj = 16 * jt + fq * 4 + i; r[i] = (ii >= jj) ? acc[i] * exp2f((float)(ii - jj) * lg2) : 0.f; }
            uint2 o; o.x = pack2(r[0], r[1]); o.y = pack2(r[2], r[3]); *(uint2*)(So + ii * 128 + 16 * jt + fq * 4) = o;
        }
        if (!(w & 1)) *(uint2*)(So + ii * 128 + 16 * (w + 1) + fq * 4) = make_uint2(0, 0);
    }
}
template <int MODE> DEV void ret_scan_phase(const int wid_s_, LAS unsigned char* lds, const bf16_t* Q, const bf16_t* Kt, bf16_t* Vt, const bf16_t* Sb, float* Eseg) {
    const int bid = obid(); if (bid >= 256) return;
    const int lane = otid() & 63, w = otid() >> 6, fr = lane & 15, fq = lane >> 4;
    const int grp = (bid & 7) * 4 + (bid >> 6), et = (bid >> 3) & 7, seg = grp & 3, bh = grp >> 2, b = bh >> 2, h = bh & 3, item = bh * 8 + et, e0 = et * 64;
    if (MODE == 0 && seg == 3) return;
    LAS bf16_t* Rt = (LAS bf16_t*)lds;
    const float lg2 = log2f(1.0f - exp2f(-5.0f - (float)h)); const float cd = exp2f(128.0f * lg2);
    f32x4 racc[4][2];
#pragma unroll
    for (int a = 0; a < 4; ++a) { racc[a][0] = (f32x4){0.f, 0.f, 0.f, 0.f}; racc[a][1] = (f32x4){0.f, 0.f, 0.f, 0.f}; }
    bf16_t* Vh0 = Vt + ((size_t)((b * 4 + h) * 128) * 512 + e0) * 128;
    const bf16_t* Kh0 = Kt + ((size_t)((b * 4 + h) * 128) * 256) * 128;
    bf16x8 vt[4][4], yk[2][4];
    if (MODE == 0) {
        for (int c = seg * 32; c < seg * 32 + 32; ++c) { const bf16_t* Vc = Vh0 + (size_t)c * 512 * 128; const bf16_t* Kc = Kh0 + (size_t)c * 256 * 128;
#pragma unroll
            for (int a = 0; a < 4; ++a)
#pragma unroll
                for (int ks = 0; ks < 4; ++ks) vt[a][ks] = *(const bf16x8*)(Vc + (a * 16 + fr) * 128 + ks * 32 + fq * 8);
#pragma unroll
            for (int dt = 0; dt < 2; ++dt)
#pragma unroll
                for (int ks = 0; ks < 4; ++ks) yk[dt][ks] = *(const bf16x8*)(Kc + (32 * w + 16 * dt + fr) * 128 + ks * 32 + fq * 8);
#pragma unroll
            for (int a = 0; a < 4; ++a) { racc[a][0] *= cd; racc[a][1] *= cd; }
#pragma unroll
            for (int dt = 0; dt < 2; ++dt)
#pragma unroll
                for (int ks = 0; ks < 4; ++ks) {
#pragma unroll
                    for (int a = 0; a < 4; ++a) racc[a][dt] = __builtin_amdgcn_mfma_f32_16x16x32_bf16(vt[a][ks], yk[dt][ks], racc[a][dt], 0, 0, 0); } }
        float* Eo = Eseg + (size_t)(item * 3 + seg) * 16384;
#pragma unroll
        for (int a = 0; a < 4; ++a)
#pragma unroll
            for (int dt = 0; dt < 2; ++dt)
#pragma unroll
                for (int i = 0; i < 4; ++i) Eo[(a * 16 + fq * 4 + i) * 256 + 32 * w + 16 * dt + fr] = racc[a][dt][i];
        return;
    }
    {
        const float cd32 = exp2f(32.0f * 128.0f * lg2); float wgt = 1.0f;
        for (int sp = seg - 1; sp >= 0; --sp) { const float* Ei = Eseg + (size_t)(item * 3 + sp) * 16384;
#pragma unroll
            for (int a = 0; a < 4; ++a)
#pragma unroll
                for (int dt = 0; dt < 2; ++dt)
#pragma unroll
                    for (int i = 0; i < 4; ++i) racc[a][dt][i] += wgt * Ei[(a * 16 + fq * 4 + i) * 256 + 32 * w + 16 * dt + fr];
            wgt *= cd32; }
#pragma unroll
        for (int a = 0; a < 4; ++a)
#pragma unroll
            for (int dt = 0; dt < 2; ++dt)
#pragma unroll
                for (int i = 0; i < 4; ++i) Rt[(a * 16 + fq * 4 + i) * 264 + 32 * w + 16 * dt + fr] = f2bf(racc[a][dt][i]);
    }
    __syncthreads();
    float qd[4];
#pragma unroll
    for (int i = 0; i < 4; ++i) qd[i] = exp2f((float)(16 * w + fq * 4 + i + 1) * lg2);
    const int nks = (16 * w + 15) / 32 + 1;
    bf16x8 xq[8], xs[4];
#define RS_LOAD(c_) do { const int cc_ = (c_); const bf16_t* Vc = Vh0 + (size_t)cc_ * 512 * 128; const bf16_t* Kc = Kh0 + (size_t)cc_ * 256 * 128; const size_t rb = (size_t)b * TSEQ + cc_ * 128; \
        const bf16_t* Sc = Sb + ((size_t)((b * 128 + cc_) * 4 + h)) * 16384; \
        _Pragma("unroll") for (int ks = 0; ks < 8; ++ks) xq[ks] = *(const bf16x8*)(Q + (rb + 16 * w + fr) * 1024 + h * 256 + ks * 32 + fq * 8); \
        _Pragma("unroll") for (int a = 0; a < 4; ++a) _Pragma("unroll") for (int ks = 0; ks < 4; ++ks) vt[a][ks] = *(const bf16x8*)(Vc + (a * 16 + fr) * 128 + ks * 32 + fq * 8); \
        _Pragma("unroll") for (int ks = 0; ks < 4; ++ks) if (ks < nks) xs[ks] = *(const bf16x8*)(Sc + (16 * w + fr) * 128 + ks * 32 + fq * 8); \
        _Pragma("unroll") for (int dt = 0; dt < 2; ++dt) _Pragma("unroll") for (int ks = 0; ks < 4; ++ks) yk[dt][ks] = *(const bf16x8*)(Kc + (32 * w + 16 * dt + fr) * 128 + ks * 32 + fq * 8); } while (0)
    const int c_end = seg * 32 + 32;
    RS_LOAD(seg * 32);
    for (int c = seg * 32; c < c_end; ++c) {
        bf16_t* Vh = Vh0 + (size_t)c * 512 * 128;
        f32x4 oacc[4];
#pragma unroll
        for (int a = 0; a < 4; ++a) oacc[a] = (f32x4){0.f, 0.f, 0.f, 0.f};
#pragma unroll
        for (int ks = 0; ks < 8; ++ks) {
#pragma unroll
            for (int a = 0; a < 4; ++a) { const bf16x8 yr = *(const LAS bf16x8*)(Rt + (a * 16 + fr) * 264 + ks * 32 + fq * 8); oacc[a] = __builtin_amdgcn_mfma_f32_16x16x32_bf16(xq[ks], yr, oacc[a], 0, 0, 0); } }
#pragma unroll
        for (int a = 0; a < 4; ++a)
#pragma unroll
            for (int i = 0; i < 4; ++i) oacc[a][i] *= qd[i];
#pragma unroll
        for (int ks = 0; ks < 4; ++ks) if (ks < nks) {
#pragma unroll
            for (int a = 0; a < 4; ++a) oacc[a] = __builtin_amdgcn_mfma_f32_16x16x32_bf16(xs[ks], vt[a][ks], oacc[a], 0, 0, 0); }
#pragma unroll
        for (int a = 0; a < 4; ++a) { racc[a][0] *= cd; racc[a][1] *= cd; }
#pragma unroll
        for (int dt = 0; dt < 2; ++dt)
#pragma unroll
            for (int ks = 0; ks < 4; ++ks) {
#pragma unroll
                for (int a = 0; a < 4; ++a) racc[a][dt] = __builtin_amdgcn_mfma_f32_16x16x32_bf16(vt[a][ks], yk[dt][ks], racc[a][dt], 0, 0, 0); }
        __syncthreads();
        if (c + 1 < c_end) RS_LOAD(c + 1);
#pragma unroll
        for (int a = 0; a < 4; ++a) { uint2 o; o.x = pack2(oacc[a][0], oacc[a][1]); o.y = pack2(oacc[a][2], oacc[a][3]); *(uint2*)(Vh + (a * 16 + fr) * 128 + 16 * w + fq * 4) = o;
#pragma unroll
            for (int dt = 0; dt < 2; ++dt)
#pragma unroll
                for (int i = 0; i < 4; ++i) Rt[(a * 16 + fq * 4 + i) * 264 + 32 * w + 16 * dt + fr] = f2bf(racc[a][dt][i]); }
        __syncthreads();
    }
#undef RS_LOAD
}
DEV void ret_norm_phase(const int wid_s_, LAS unsigned char* lds, const bf16_t* Ot, bf16_t* ON) {
    LAS bf16_t* T = (LAS bf16_t*)lds;
    const int lane = otid() & 63, w = otid() >> 6, tid = otid();
    for (int item = obid(); item < 2048; item += gridDim.x) {
        const int tt = item & 255, h = (item >> 8) & 3, b = item >> 10; const int t0 = tt * 64;
        { const bf16_t* src = Ot + ((size_t)(((b * 4 + h) * 128 + (tt >> 1)) * 512 + tid)) * 128 + (tt & 1) * 64;
#pragma unroll
            for (int q = 0; q < 8; ++q) { const uint4 v = *(const uint4*)(src + q * 8); LAS unsigned* d = (LAS unsigned*)(T + tid * 66 + q * 8); d[0] = v.x; d[1] = v.y; d[2] = v.z; d[3] = v.w; } }
        __syncthreads();
        for (int k = 0; k < 8; ++k) { const int tk = w * 8 + k; float v[8]; float s = 0.f;
#pragma unroll
            for (int q = 0; q < 8; ++q) { v[q] = bf2f(T[(lane + 64 * q) * 66 + tk]); s += v[q]; }
            const float mu = wave_sum(s) * (1.0f / 512.0f); float qq = 0.f;
#pragma unroll
            for (int q = 0; q < 8; ++q) { v[q] -= mu; qq += v[q] * v[q]; }
            const float rs = rsqrtf(wave_sum(qq) * (1.0f / 512.0f) + 1e-5f);
            bf16_t* dst = ON + ((size_t)b * TSEQ + t0 + tk) * 2048 + h * 512;
#pragma unroll
            for (int q = 0; q < 8; ++q) dst[lane + 64 * q] = f2bf(v[q] * rs); }
        __syncthreads();
    }
}

struct S5Coef { float are, aim; float bre[16], bim[16]; };
constexpr size_t S5TAB_OFF = 56ull << 20;
DEV void s5_build_table(const int wid_s_, CP p, float* tab) {
    for (int gn = obid() * 512 + otid(); gn < 4096; gn += gridDim.x * 512) { const int g = gn >> 6;
        const double dt = exp((double)p->in[I_S5_LS][g]); const double ar = p->in[I_S5_ARE][gn], ai = p->in[I_S5_AIM][gn];
        const double mag = exp(dt * ar); double sn, cs; sincos(dt * ai, &sn, &cs);
        const double abr = mag * cs, abi = mag * sn, den = ar * ar + ai * ai;
        const double fre = ((abr - 1.0) * ar + abi * ai) / den, fim = (abi * ar - (abr - 1.0) * ai) / den;
        float* t = tab + (size_t)gn * 36; t[0] = (float)abr; t[1] = (float)abi;
        const double mL = exp(64.0 * dt * ar); double s2, c2; sincos(64.0 * dt * ai, &s2, &c2); t[2] = (float)(mL * c2); t[3] = (float)(mL * s2);
        for (int q = 0; q < 16; ++q) { const double br = p->in[I_S5_BRE][gn * 16 + q], bi = p->in[I_S5_BIM][gn * 16 + q]; t[4 + q] = (float)(fre * br - fim * bi); t[20 + q] = (float)(fre * bi + fim * br); } }
}
DEV void s5_coef(CP p, int g, int n, S5Coef& c, float* aLre, float* aLim) {
    const float* t = (const float*)(p->ws + S5TAB_OFF) + (size_t)(g * 64 + n) * 36;
    const f32x4 h = *(const f32x4*)t; c.are = h[0]; c.aim = h[1]; if (aLre) { *aLre = h[2]; *aLim = h[3]; }
#pragma unroll
    for (int q4 = 0; q4 < 4; ++q4) { const f32x4 a = *(const f32x4*)(t + 4 + q4 * 4), b = *(const f32x4*)(t + 20 + q4 * 4);
#pragma unroll
        for (int i = 0; i < 4; ++i) { c.bre[q4 * 4 + i] = a[i]; c.bim[q4 * 4 + i] = b[i]; } }
}
template <bool OUT> DEV void s5_scan_phase(const int wid_s_, CP p, LAS unsigned char* lds, const float* U, float2* E, bf16_t* ACT) {
    const int lane = otid() & 63, w = wid_s_, fr = lane & 15, fq = lane >> 4; const int g = (obid() & 7) * 8 + w;
    S5Coef cf; s5_coef(p, g, lane, cf, nullptr, nullptr);
    typedef float f32x2s __attribute__((ext_vector_type(2)));
    f32x2s cb[16];
#pragma unroll
    for (int q = 0; q < 16; ++q) cb[q] = (f32x2s){cf.bre[q], cf.bim[q]};
    LAS bf16_t* hb = (LAS bf16_t*)lds + w * (16 * 136);
    bf16x8 cfrag[4]; float dsk = 0.f;
    if (OUT) { dsk = p->in[I_S5_D][g * 16 + fr];
#pragma unroll
        for (int ks = 0; ks < 4; ++ks) { const bool im = ks >= 2; const float* src = (im ? p->in[I_S5_CIM] : p->in[I_S5_CRE]) + (g * 16 + fr) * 64 + (ks & 1) * 32 + fq * 8;
#pragma unroll
            for (int i = 0; i < 8; ++i) cfrag[ks][i] = (short)f2bf(im ? -src[i] : src[i]); } }
    for (int item = obid(); item < 4096; item += gridDim.x) {
        const int ch = (item >> 3) & 255, b = item >> 11; const size_t row0 = (size_t)b * TSEQ + ch * 64;
        float hre = 0.f, him = 0.f; const size_t eidx = ((size_t)(b * 256 + ch) * 64 + g) * 64 + lane;
        if (OUT) { const float2 h0 = E[eidx]; hre = h0.x; him = h0.y; }
        for (int t16 = 0; t16 < 64; t16 += 16) {
#pragma unroll 4
            for (int tt = 0; tt < 16; ++tt) { const float* up = U + (row0 + t16 + tt) * 1024 + g * 16; f32x2s bu = {0.f, 0.f};
#pragma unroll
                for (int q4 = 0; q4 < 4; ++q4) { const f32x4 uv = *(const f32x4*)(up + q4 * 4);
#pragma unroll
                    for (int i = 0; i < 4; ++i) bu += cb[q4 * 4 + i] * uv[i]; }
                const float nr = cf.are * hre - cf.aim * him + bu[0], ni = cf.are * him + cf.aim * hre + bu[1]; hre = nr; him = ni;
                if (OUT) { hb[tt * 136 + lane] = f2bf(hre); hb[tt * 136 + 64 + lane] = f2bf(him); } }
            if (OUT) { f32x4 acc = {0.f, 0.f, 0.f, 0.f};
#pragma unroll
                for (int ks = 0; ks < 4; ++ks) { const bf16x8 hf = *(const LAS bf16x8*)(hb + fr * 136 + ks * 32 + fq * 8); acc = __builtin_amdgcn_mfma_f32_16x16x32_bf16(hf, cfrag[ks], acc, 0, 0, 0); }
#pragma unroll
                for (int i = 0; i < 4; ++i) { const size_t o = (row0 + t16 + fq * 4 + i) * 1024 + g * 16 + fr; ACT[o] = f2bf(geluf_(acc[i] + dsk * U[o])); } }
        }
        if (!OUT) E[eidx] = make_float2(hre, him);
    }
}
DEV void s5_carry_phase(const int wid_s_, CP p, float2* E) {
    const int gid = obid() * 512 + otid(); if (gid >= 8192) return;
    const int b = gid >> 12, gn = gid & 4095; S5Coef cf; float are, aim; s5_coef(p, gn >> 6, gn & 63, cf, &are, &aim);
    float hre = 0.f, him = 0.f; float2* e = E + (size_t)b * 256 * 4096 + gn;
    for (int c0 = 0; c0 < 256; c0 += 8) { float2 v[8];
#pragma unroll
        for (int k = 0; k < 8; ++k) v[k] = e[(size_t)(c0 + k) * 4096];
#pragma unroll
        for (int k = 0; k < 8; ++k) { e[(size_t)(c0 + k) * 4096] = make_float2(hre, him); const float nr = are * hre - aim * him + v[k].x, ni = are * him + aim * hre + v[k].y; hre = nr; him = ni; } }
}

DEV void rw_prep_phase(const int wid_s_, const float* X, bf16_t* A2, const float2* st, const float* g, const float* b) {
    for (long i = (long)obid() * 512 + otid(); i < (long)M_TOK * 256; i += (long)gridDim.x * 512) {
        const int row = (int)(i >> 8), c = (int)(i & 255) * 4; const f32x4 gv = *(const f32x4*)(g + c), bv = *(const f32x4*)(b + c);
        const float2 t = st[row]; const f32x4 v = (*(const f32x4*)(X + (size_t)row * 1024 + c) - t.x) * t.y * gv + bv;
        f32x4 pv = {0.f, 0.f, 0.f, 0.f}; if (row & (TSEQ - 1)) { const float2 tp = st[row - 1]; pv = (*(const f32x4*)(X + (size_t)(row - 1) * 1024 + c) - tp.x) * tp.y * gv + bv; }
        uint2 o; o.x = pack2(v[0], v[1]); o.y = pack2(v[2], v[3]); *(uint2*)(A2 + (size_t)row * 2048 + c) = o;
        const f32x4 d = pv - v; o.x = pack2(d[0], d[1]); o.y = pack2(d[2], d[3]); *(uint2*)(A2 + (size_t)row * 2048 + 1024 + c) = o;
    }
}
DEV void rw_scan_phase(const int wid_s_, CP p, LAS unsigned char* lds, const bf16_t* R, const bf16_t* Kk, const bf16_t* V, const bf16_t* EW, const bf16_t* AA, bf16_t* Y) {
    const int bid = obid(); if (bid >= 256) return;
    const int bh = (bid & 7) * 4 + (bid >> 6), rg = (bid >> 3) & 7, b = bh >> 4, h = bh & 15;
    const int tid = otid();
    constexpr int TC = 32, BUF = 5 * TC * 64 + TC * 8, NCH = TSEQ / TC;
    LAS float* L0 = (LAS float*)lds; LAS float* YB = L0 + 2 * BUF;
    const bool isprod = (wid_s_ & 2) != 0; const int pw = (wid_s_ >> 2) * 2 + (wid_s_ & 1), pl = tid & 63, pt = pw * 64 + pl, phalf = pl >> 5, pc2 = (pl & 31) * 2;
    float kkw0 = 0.f, kkw1 = 0.f, kaw0 = 0.f, kaw1 = 0.f;
    if (isprod) { kkw0 = p->in[I_RW_KK][h * 64 + pc2]; kkw1 = p->in[I_RW_KK][h * 64 + pc2 + 1]; kaw0 = p->in[I_RW_KA][h * 64 + pc2]; kaw1 = p->in[I_RW_KA][h * 64 + pc2 + 1]; }
    unsigned pk[4], pa[4], pew[4], pr[4], pv[4];
    auto pload = [&](int c) {
#pragma unroll
        for (int i = 0; i < 4; ++i) { const int tok = pw * 8 + i * 2 + phalf; const size_t g = ((size_t)b * TSEQ + c * TC + tok) * 1024 + h * 64 + pc2;
            pk[i] = *(const unsigned*)(Kk + g); pa[i] = *(const unsigned*)(AA + g); pew[i] = *(const unsigned*)(EW + g); pr[i] = *(const unsigned*)(R + g);
            pv[i] = pc2 < 8 ? *(const unsigned*)(V + g - pc2 + rg * 8 + pc2) : 0u; }
    };
    typedef float f32x2p __attribute__((ext_vector_type(2)));
    auto pstage = [&](int buf) { LAS float* B = L0 + buf * BUF;
#pragma unroll
        for (int i = 0; i < 4; ++i) { const int tok = pw * 8 + i * 2 + phalf;
            const float k0 = __uint_as_float(pk[i] << 16), k1 = __uint_as_float(pk[i] & 0xffff0000u), a0 = __uint_as_float(pa[i] << 16), a1 = __uint_as_float(pa[i] & 0xffff0000u);
            const float e0 = __uint_as_float(pew[i] << 16), e1 = __uint_as_float(pew[i] & 0xffff0000u);
            const float kv0 = k0 * kkw0, kv1 = k1 * kkw1; const float s16 = sum16(kv0 * kv0 + kv1 * kv1);
            const float t0 = rdlane(s16, 0) + rdlane(s16, 16), t1 = rdlane(s16, 32) + rdlane(s16, 48);
            const float rn = __builtin_amdgcn_rsqf(fmaxf(phalf ? t1 : t0, 1e-24f)); const float kk0 = kv0 * rn, kk1 = kv1 * rn;
            LAS float* q = B + tok * 64 + pc2;
            *(LAS f32x2p*)(q + 0 * TC * 64) = (f32x2p){__expf(-e0), __expf(-e1)}; *(LAS f32x2p*)(q + 1 * TC * 64) = (f32x2p){kk0, kk1}; *(LAS f32x2p*)(q + 2 * TC * 64) = (f32x2p){kk0 * a0, kk1 * a1};
            *(LAS f32x2p*)(q + 3 * TC * 64) = (f32x2p){k0 * (1.0f + (a0 - 1.0f) * kaw0), k1 * (1.0f + (a1 - 1.0f) * kaw1)};
            *(LAS f32x2p*)(q + 4 * TC * 64) = (f32x2p){__uint_as_float(pr[i] << 16), __uint_as_float(pr[i] & 0xffff0000u)};
            if (pc2 < 8) *(LAS f32x2p*)(B + 5 * TC * 64 + tok * 8 + pc2) = (f32x2p){__uint_as_float(pv[i] << 16), __uint_as_float(pv[i] & 0xffff0000u)}; }
    };
    auto store_y = [&](int c) { Y[((size_t)b * TSEQ + c * TC + (pt >> 3)) * 1024 + h * 64 + rg * 8 + (pt & 7)] = f2bf(YB[(c & 1) * TC * 8 + pt]); };
    if (isprod) { pload(0); pstage(0); pload(1); }
    __syncthreads();
    typedef float f32x2 __attribute__((ext_vector_type(2)));
    f32x2 Sa = {0.f, 0.f}, Sb2 = {0.f, 0.f}; const int rowi = tid >> 4, c4 = (tid & 15) * 4, l16 = tid & 15;
    const bool sel8 = (l16 & 8) != 0, sel4 = (l16 & 4) != 0, sel2 = (l16 & 2) != 0, sel1 = (l16 & 1) != 0;
    if (tid < 128) __builtin_amdgcn_s_setprio(3);
    for (int c = 0; c < NCH; ++c) {
        const int buf = c & 1;
        if (isprod) { if (c + 1 < NCH) pstage(buf ^ 1); if (c + 2 < NCH) pload(c + 2); if (c > 0) store_y(c - 1); }
        else if (tid < 128) { LAS float* B = L0 + buf * BUF; LAS float* yb = YB + buf * TC * 8;
            f32x4 w[4], kk[4], bb[4], km[4], rr[4]; float v[4];
#define RW_LOAD(slot, tk) do { w[slot] = *(const LAS f32x4*)(B + 0 * TC * 64 + (tk) * 64 + c4); kk[slot] = *(const LAS f32x4*)(B + 1 * TC * 64 + (tk) * 64 + c4); bb[slot] = *(const LAS f32x4*)(B + 2 * TC * 64 + (tk) * 64 + c4); \
                km[slot] = *(const LAS f32x4*)(B + 3 * TC * 64 + (tk) * 64 + c4); rr[slot] = *(const LAS f32x4*)(B + 4 * TC * 64 + (tk) * 64 + c4); v[slot] = B[5 * TC * 64 + (tk) * 8 + rowi]; } while (0)
#define RW_STEP(slot, j) do { \
                const f32x2 kA = {kk[slot][0], kk[slot][1]}, kB = {kk[slot][2], kk[slot][3]}; const f32x2 wA = {w[slot][0], w[slot][1]}, wB = {w[slot][2], w[slot][3]}; \
                const f32x2 mA = {km[slot][0], km[slot][1]}, mB = {km[slot][2], km[slot][3]}; const f32x2 bA = {bb[slot][0], bb[slot][1]}, bB = {bb[slot][2], bb[slot][3]}; \
                const f32x2 rA = {rr[slot][0], rr[slot][1]}, rB = {rr[slot][2], rr[slot][3]}; \
                const f32x2 pd = Sa * kA + Sb2 * kB; const float sa = -sum16(pd[0] + pd[1]); \
                const f32x2 TA = Sa * wA + mA * v[slot], TB = Sb2 * wB + mB * v[slot]; \
                Sa = TA + bA * sa; Sb2 = TB + bB * sa; \
                const f32x2 py = Sa * rA + Sb2 * rB; yp[j] = py[0] + py[1]; } while (0)
#pragma unroll 1
            for (int t16 = 0; t16 < TC; t16 += 16) {
                float yp[16];
                RW_LOAD(0, t16); RW_LOAD(1, t16 + 1); RW_LOAD(2, t16 + 2);
#pragma unroll
                for (int j = 0; j < 16; j += 4) {
                    if (j + 3 < 16) RW_LOAD(3, t16 + j + 3);
                    RW_STEP(0, j);
                    if (j + 4 < 16) RW_LOAD(0, t16 + j + 4);
                    RW_STEP(1, j + 1);
                    if (j + 5 < 16) RW_LOAD(1, t16 + j + 5);
                    RW_STEP(2, j + 2);
                    if (j + 6 < 16) RW_LOAD(2, t16 + j + 6);
                    RW_STEP(3, j + 3);
                }
                float y8[8], y4[4], y2[2];
#pragma unroll
                for (int q = 0; q < 8; ++q) { const float keep = sel8 ? yp[q + 8] : yp[q], send = sel8 ? yp[q] : yp[q + 8]; y8[q] = keep + dppf<0x140>(send); }
#pragma unroll
                for (int q = 0; q < 4; ++q) { const float keep = sel4 ? y8[q + 4] : y8[q], send = sel4 ? y8[q] : y8[q + 4]; y4[q] = keep + dppf<0x141>(send); }
#pragma unroll
                for (int q = 0; q < 2; ++q) { const float keep = sel2 ? y4[q + 2] : y4[q], send = sel2 ? y4[q] : y4[q + 2]; y2[q] = keep + dppf<0x4E>(send); }
                { const float keep = sel1 ? y2[1] : y2[0], send = sel1 ? y2[0] : y2[1]; yb[(t16 + l16) * 8 + rowi] = keep + dppf<0xB1>(send); }
            }
#undef RW_LOAD
#undef RW_STEP
        }
        __syncthreads();
    }
    __builtin_amdgcn_s_setprio(0);
    if (isprod) store_y(NCH - 1);
}
DEV void rw_post_phase(const int wid_s_, CP p, const bf16_t* Y, bf16_t* R, const bf16_t* Kk, const bf16_t* V, const bf16_t* AA, const bf16_t* G) {
    const int lane = otid() & 63, w = otid() >> 6;
    for (long it = (long)obid() * 8 + w; it < (long)M_TOK * 4; it += (long)gridDim.x * 8) {
        const int hq = (int)(it & 3); const size_t g0 = (size_t)(it >> 2) * 1024 + hq * 256 + lane; const int ch0 = hq * 256 + lane;
        float y[4], r[4], k[4], v[4], a[4], gg[4];
#pragma unroll
        for (int q = 0; q < 4; ++q) { const size_t g = g0 + q * 64; y[q] = bf2f(Y[g]); r[q] = bf2f(R[g]); k[q] = bf2f(Kk[g]); v[q] = bf2f(V[g]); a[q] = bf2f(AA[g]); gg[q] = bf2f(G[g]); }
#pragma unroll
        for (int q = 0; q < 4; ++q) { const int ch = ch0 + q * 64;
            const float mu = wave_sum_fast(y[q]) * (1.0f / 64.0f); const float d = y[q] - mu; const float var = wave_sum_fast(d * d) * (1.0f / 64.0f);
            const float yn = d * rsqrtf(var + 64e-5f) * p->in[I_RW_LG][ch] + p->in[I_RW_LB][ch];
            const float km = k[q] * (1.0f + (a[q] - 1.0f) * p->in[I_RW_KA][ch]); const float bonus = wave_sum_fast(r[q] * km * p->in[I_RW_RK][ch]);
            R[g0 + q * 64] = f2bf((yn + bonus * v[q]) * gg[q]); }
    }
}

DEV void lru_conv_phase(const int wid_s_, CP p, const bf16_t* XR, bf16_t* XC) {
    const float* cw = p->in[I_LRU_CW]; const float* cb = p->in[I_LRU_CB];
    for (long i = (long)obid() * 512 + otid(); i < (long)M_TOK * 128; i += (long)gridDim.x * 512) {
        const int row = (int)(i >> 7), c = (int)(i & 127) * 8, t = row & (TSEQ - 1); float acc[8];
#pragma unroll
        for (int q = 0; q < 8; ++q) acc[q] = cb[c + q];
#pragma unroll
        for (int j = 0; j < 4; ++j) { if (t - 3 + j < 0) continue; const uint4 v = *(const uint4*)(XR + (size_t)(row - 3 + j) * 1024 + c); const unsigned u[4] = {v.x, v.y, v.z, v.w};
#pragma unroll
            for (int q = 0; q < 4; ++q) { acc[2 * q] += cw[j * 1024 + c + 2 * q] * bf2f((bf16_t)(u[q] & 0xffff)); acc[2 * q + 1] += cw[j * 1024 + c + 2 * q + 1] * bf2f((bf16_t)(u[q] >> 16)); } }
        uint4 o; o.x = pack2(acc[0], acc[1]); o.y = pack2(acc[2], acc[3]); o.z = pack2(acc[4], acc[5]); o.w = pack2(acc[6], acc[7]); *(uint4*)(XC + (size_t)row * 1024 + c) = o;
    }
}
template <bool OUT> DEV void lru_scan_phase(const int wid_s_, const unsigned* PK, float2* CP, bf16_t* GATE) {
    for (int item = obid(); item < 1024; item += gridDim.x) {
        const int half = item & 1, chk = (item >> 1) & 255, b = item >> 9; const int ch = half * 512 + otid(); const size_t row0 = (size_t)b * TSEQ + chk * 64;
        const size_t ci = (size_t)(b * 256 + chk) * 1024 + ch;
        float h = 0.f, P = 1.f; if (OUT) h = CP[ci].x;
#pragma unroll 8
        for (int t = 0; t < 64; ++t) { const size_t g = (row0 + t) * 1024 + ch; const unsigned pw = PK[g]; const float a = 1.0f - __uint_as_float(pw << 16), x = __uint_as_float(pw & 0xffff0000u); h = a * h + x; P *= a;
            if (OUT) GATE[g] = f2bf(h * bf2f(GATE[g])); }
        if (!OUT) CP[ci] = make_float2(P, h);
    }
}
DEV void lru_carry_phase(const int wid_s_, float2* CP) {
    const int gid = obid() * 512 + otid(); if (gid >= 2048) return;
    const int b = gid >> 10, ch = gid & 1023; float2* e = CP + (size_t)b * 256 * 1024 + ch; float h = 0.f;
    for (int c0 = 0; c0 < 256; c0 += 8) { float2 v[8];
#pragma unroll
        for (int k = 0; k < 8; ++k) v[k] = e[(size_t)(c0 + k) * 1024];
#pragma unroll
        for (int k = 0; k < 8; ++k) { e[(size_t)(c0 + k) * 1024].x = h; h = v[k].x * h + v[k].y; } }
}

constexpr size_t BAR_OFF = 58ull << 20;
#define XB_TMO      128
#define XB_XCNT(j)  (256  + 64 * (j))
#define XB_XSUB(j)  (1280 + 64 * (j))
#define XB_XGEN(j)  (2304 + 64 * (j))
#define XB_TOP      3328
#define XB_TOPGEN   3392
#define XB_SPIN_CAP (1u << 18)
DEV unsigned xb_ld(unsigned* p) { return __hip_atomic_load(p, __ATOMIC_RELAXED, __HIP_MEMORY_SCOPE_AGENT); }
DEV unsigned xb_add(unsigned* p, unsigned v) { return __hip_atomic_fetch_add(p, v, __ATOMIC_RELAXED, __HIP_MEMORY_SCOPE_AGENT); }
DEV unsigned xb_xcc_id() { return (unsigned)__builtin_amdgcn_s_getreg((3 << 11) | 20) & 0xFu; }
#define XB_SPIN(cond, bar) do { unsigned _sp = 0; while (cond) { __builtin_amdgcn_s_sleep(1); \
    if ((++_sp & 255u) == 0u) { if (xb_ld(&(bar)[XB_TMO])) break; if (_sp > XB_SPIN_CAP) { atomicAdd(&(bar)[XB_TMO], 1u); break; } } } } while (0)
DEV void xcd_complete(unsigned* bar, unsigned x, unsigned& nloc, unsigned& nx) {
    const unsigned G = gridDim.x; unsigned sum, cnt, mine, sp = 0u;
    for (;;) { sum = 0u; cnt = 0u; mine = 0u;
#pragma unroll
        for (unsigned j = 0; j < 16; ++j) { const unsigned c = xb_ld(&bar[XB_XCNT(j)]); sum += c; cnt += (c > 0u) ? 1u : 0u; mine = (j == x) ? c : mine; }
        if (sum == G) break;
        __builtin_amdgcn_s_sleep(1);
        if ((++sp & 255u) == 0u) { if (xb_ld(&bar[XB_TMO])) break; if (sp > XB_SPIN_CAP) { atomicAdd(&bar[XB_TMO], 1u); break; } } }
    nloc = mine > 0u ? mine : 1u; nx = cnt > 0u ? cnt : 1u;
}
DEV void grid_barrier(const int wid_s_, unsigned* bar, volatile LAS unsigned* st) {
    asm volatile("s_waitcnt vmcnt(0)" ::: "memory");
    __syncthreads();
    if (otid() == 0) {
        __builtin_amdgcn_s_waitcnt(0);
        const unsigned x = xb_xcc_id();
        unsigned nloc = st[0], nx = st[1];
        if (nloc == 0u) { xcd_complete(bar, x, nloc, nx); st[0] = nloc; st[1] = nx; }
        const unsigned old = xb_add(&bar[XB_XSUB(x)], 1u);
        const unsigned gen = old / nloc;
        if (old + 1u == (gen + 1u) * nloc) {
            __builtin_amdgcn_fence(__ATOMIC_RELEASE, "agent");
            asm volatile("s_waitcnt vmcnt(0)" ::: "memory");
            const unsigned og = xb_add(&bar[XB_TOP], 1u);
            const unsigned tg = og / nx;
            if (og + 1u == (tg + 1u) * nx) xb_add(&bar[XB_TOPGEN], 1u);
            else XB_SPIN(xb_ld(&bar[XB_TOPGEN]) == tg, bar);
            __builtin_amdgcn_fence(__ATOMIC_ACQUIRE, "agent");
            xb_add(&bar[XB_XGEN(x)], 1u);
            asm volatile("s_waitcnt vmcnt(0)" ::: "memory");
        } else {
            XB_SPIN(xb_ld(&bar[XB_XGEN(x)]) == gen, bar);
            __builtin_amdgcn_fence(__ATOMIC_ACQUIRE, "agent");
            asm volatile("s_waitcnt vmcnt(0)" ::: "memory");
        }
    }
    __syncthreads();
}
template <class T> DEV T* olaunder(T* q) { asm volatile("" : "+s"(q)); return q; }
#define PTRS CP p = (CP)__builtin_amdgcn_kernarg_segment_ptr(); asm volatile("" : "+s"(p)); unsigned char* ws = olaunder(p->ws); float* X = olaunder(p->x); bf16_t* W = (bf16_t*)ws; bf16_t* XB = (bf16_t*)(ws + UNIT); unsigned char* AR = ws + 2 * UNIT; bf16_t* WX = W + W_MIX; \
    (void)X; (void)W; (void)XB; (void)AR; (void)WX;
#define GEMM(A_, lda_, Bt_, K_, N_, agrp_, E_) do { pg8::Gemm g; g.A = (A_); g.Bt = (Bt_); g.lda = (lda_); g.K = (K_); g.nM = M_TOK / 256; g.nN = (N_) / 256; g.a_grp = (agrp_); pg8::gemm_phase(wid_s_, lds, g, E_); } while (0)
#define STATS ((float2*)(ws + (59ull << 20)))
#define LNG_(L) (p->in[I_LNG] + (L) * 1024)
#define LNB_(L) (p->in[I_LNB] + (L) * 1024)
#define CS_ ((float2*)(AR + 5 * UNIT + UNIT / 2))
#define RQ ((bf16_t*)AR)
#define RKr ((bf16_t*)(AR + UNIT))
#define RKt ((bf16_t*)(AR + 2 * UNIT))
#define RVt ((bf16_t*)(AR + 3 * UNIT))
#define RSb ((bf16_t*)(AR + 5 * UNIT))
#define RES ((float*)(AR + 5 * UNIT + 3 * (UNIT / 4)))
#define SU ((float*)AR)
#define SACT ((bf16_t*)(AR + 2 * UNIT))
#define SZ ((bf16_t*)(AR + 3 * UNIT))
#define SE5 ((float2*)(AR + 4 * UNIT))
#define WA2 ((bf16_t*)AR)
#define WR ((bf16_t*)(AR + 3 * UNIT))
#define WK ((bf16_t*)(AR + 4 * UNIT))
#define WV ((bf16_t*)(AR + 5 * UNIT))
#define WG ((bf16_t*)(AR + 2 * UNIT))
#define WL XB
#define WY XB
#define WEW ((bf16_t*)AR)
#define WAA ((bf16_t*)(AR + UNIT))
#define LGATE ((bf16_t*)AR)
#define LXC ((bf16_t*)(AR + UNIT))
#define LAT ((float*)(AR + 2 * UNIT))
#define LINP ((float*)(AR + 4 * UNIT))
#define LXR ((bf16_t*)(AR + 4 * UNIT))
#define LCP ((float2*)(ws + (60ull << 20)))
#define PHASE(...) do { if (ph >= lo && ph < hi) { PTRS __VA_ARGS__; if (ph + 1 < hi) { if (ph == 0) grid.sync(); else grid_barrier(wid_s_, (unsigned*)(ws + BAR_OFF), (volatile LAS unsigned*)(lds + 131072)); } } ++ph; } while (0)
#define FFN_PHASES(s) \
    PHASE({ EpiFfnUp E{(bf16_t*)AR}; GEMM(XB, 1024, W + ((s) ? W_UP1 : W_UP0), 1024, 2 * DFF, 0, E); }); \
    PHASE({ constexpr int PL = layer * 3 + (s) * 2 - 1; EpiResid E{X, PL >= 0 ? X : p->in[I_X], 0.5f, PL >= 0 ? STATS : nullptr, LNG_(PL >= 0 ? PL : 0), LNB_(PL >= 0 ? PL : 0)}; GEMM((bf16_t*)AR, DFF, W + ((s) ? W_DN1 : W_DN0), DFF, 1024, 0, E); }); \
    PHASE({ if constexpr (layer == 2 && (s) == 0) ln_prep_phase(wid_s_, X, WA2, LNG_(6), LNB_(6), STATS); \
            else ln_phase(wid_s_, X, XB, LNG_(layer * 3 + (s) * 2), LNB_(layer * 3 + (s) * 2), STATS, layer * 3 + (s) * 2 == 11); \
            if ((s) == 1 && layer < 3) convert_layer(wid_s_, p, layer + 1, (float*)shm); });
#define SEQ_RET \
        PHASE({ EpiRetQKV E{RQ, RKr, RKt, RVt, CS_}; GEMM(XB, 1024, WX, 1024, 4096, 0, E); }); \
        PHASE({ ret_scan_phase<0>(wid_s_, lds, RQ, RKt, RVt, RSb, RES); ret_s_phase(wid_s_, RQ, RKr, RSb); }); \
        PHASE({ ret_scan_phase<1>(wid_s_, lds, RQ, RKt, RVt, RSb, RES); }); \
        PHASE({ ret_norm_phase(wid_s_, lds, RVt, RQ); }); \
        PHASE({ EpiMulBf E{RQ, 2048, 0, nullptr}; GEMM(XB, 1024, WX + (size_t)4096 * 1024, 1024, 2048, 0, E); });
#define SEQ_S5 \
        PHASE({ EpiF32 E{SU, 1024}; GEMM(XB, 1024, WX, 1024, 1024, 0, E); }); \
        PHASE({ s5_scan_phase<false>(wid_s_, p, lds, SU, SE5, SACT); }); \
        PHASE({ s5_carry_phase(wid_s_, p, SE5); }); \
        PHASE({ s5_scan_phase<true>(wid_s_, p, lds, SU, SE5, SACT); }); \
        PHASE({ EpiMulBf E{SACT, 1024, 1, SZ}; GEMM(SACT, 1024, WX + 1048576, 1024, 1024, 0, E); });
#define SEQ_RW \
        PHASE({ EpiRw1 E{WR, WL}; GEMM(WA2, 2048, WX, 2048, 3328, 0, E); }); \
        PHASE({ EpiRw2 E{WEW, p->in[I_RW_W0], p->in[I_RW_A0]}; GEMM(WL, 256, WX + 6815744, 256, 3072, 0, E); }); \
        PHASE({ rw_scan_phase(wid_s_, p, lds, WR, WK, WV, WEW, WAA, WY); }); \
        PHASE({ rw_post_phase(wid_s_, p, WY, WR, WK, WV, WAA, WG); });
#define SEQ_LRU \
        PHASE({ EpiLruIn E{LGATE, LXR}; GEMM(XB, 1024, WX, 1024, 2048, 0, E); }); \
        PHASE({ lru_conv_phase(wid_s_, p, LXR, LXC); }); \
        PHASE({ EpiLruAx E{(unsigned*)LAT, LXC, p->in[I_LRU_BA], p->in[I_LRU_BX], p->in[I_LRU_LAM]}; GEMM(LXC, 1024, WX + 2097152, 256, 2048, 2, E); }); \
        PHASE({ lru_scan_phase<false>(wid_s_, (const unsigned*)LAT, LCP, LGATE); }); \
        PHASE({ lru_carry_phase(wid_s_, LCP); }); \
        PHASE({ lru_scan_phase<true>(wid_s_, (const unsigned*)LAT, LCP, LGATE); });
#ifndef DUPL
#define DUPL 0
#endif
template <int layer> DEV void run_layer(const int wid_s_, LAS unsigned char* lds, unsigned char* shm, cg::grid_group& grid, int& ph, const int lo, const int hi) {
    FFN_PHASES(0)
    if constexpr (layer == 0) {
        SEQ_RET
        if constexpr ((DUPL & 1) != 0) { SEQ_RET }
        PHASE({ EpiResid E{X, X, 1.0f, STATS, LNG_(layer * 3), LNB_(layer * 3)}; GEMM(RQ, 2048, WX + 6291456, 2048, 1024, 0, E); });
    } else if constexpr (layer == 1) {
        SEQ_S5
        if constexpr ((DUPL & 2) != 0) { SEQ_S5 }
        PHASE({ EpiResid E{X, X, 1.0f, STATS, LNG_(layer * 3), LNB_(layer * 3)}; GEMM(SZ, 1024, WX + 2097152, 1024, 1024, 0, E); });
    } else if constexpr (layer == 2) {
        SEQ_RW
        if constexpr ((DUPL & 4) != 0) { SEQ_RW }
        PHASE({ EpiResid E{X, X, 1.0f, STATS, LNG_(layer * 3), LNB_(layer * 3)}; GEMM(WR, 1024, WX + 7602176, 1024, 1024, 0, E); });
    } else {
        SEQ_LRU
        if constexpr ((DUPL & 8) != 0) { SEQ_LRU }
        PHASE({ EpiResid E{X, X, 1.0f, STATS, LNG_(layer * 3), LNB_(layer * 3)}; GEMM(LGATE, 1024, WX + 2621440, 1024, 1024, 0, E); });
    }
    PHASE({ ln_phase(wid_s_, X, XB, LNG_(layer * 3 + 1), LNB_(layer * 3 + 1), STATS, false); });
    FFN_PHASES(1)
}
__global__ void __launch_bounds__(512) fwd_megakernel(Params p0) {
    extern __shared__ __attribute__((aligned(16))) unsigned char shm[];
    LAS unsigned char* lds = (LAS unsigned char*)shm;
    cg::grid_group grid = cg::this_grid();
    const int wid_s_ = __builtin_amdgcn_readfirstlane((int)(threadIdx.x >> 6));
    int ph = 0; const int lo = p0.ph_lo, hi = p0.ph_hi;
    if (threadIdx.x < 4) ((LAS unsigned*)(lds + 131072))[threadIdx.x] = 0u;
    if (threadIdx.x == 0) (void)xb_add(&((unsigned*)(p0.ws + BAR_OFF))[XB_XCNT(xb_xcc_id())], 1u);
    __syncthreads();
    PHASE({
        const float* xin = p->in[I_X];
        for (long i = (long)obid() * 512 + otid(); i < (long)M_TOK * 256; i += (long)gridDim.x * 512) { const f32x4 v = *(const f32x4*)(xin + i * 4);
            uint2 o; o.x = pack2(v[0], v[1]); o.y = pack2(v[2], v[3]); *(uint2*)(XB + i * 4) = o; }
        for (long i = (long)obid() * 512 + otid(); i < (long)TSEQ * 128; i += (long)gridDim.x * 512) { const int t = (int)(i >> 7), j = (int)(i & 127);
            const double inv = exp2(-(double)j / 128.0 * 13.287712379549449); double sn, cs; sincos((double)t * inv, &sn, &cs); CS_[i] = make_float2((float)cs, (float)sn); }
        s5_build_table(wid_s_, p, (float*)(ws + S5TAB_OFF));
        convert_layer(wid_s_, p, 0, (float*)shm);
    });
    run_layer<0>(wid_s_, lds, shm, grid, ph, lo, hi);
    run_layer<1>(wid_s_, lds, shm, grid, ph, lo, hi);
    run_layer<2>(wid_s_, lds, shm, grid, ph, lo, hi);
    run_layer<3>(wid_s_, lds, shm, grid, ph, lo, hi);
}

constexpr int N_PHASES = 1 + 4 * 6 + 6 + 6 + 6 + 7 + 4;
constexpr int LDS_BYTES = 131072 + 16;

extern "C" void kernel_launch(void* const* d_in, const int* in_sizes, int n_in, void* d_out, int out_size, void* d_ws, size_t ws_size, hipStream_t stream) {
    static int grid = 0;
    if (grid == 0) {
        int dev = 0, cus = 0, per_cu = 0;
        hipGetDevice(&dev); hipDeviceGetAttribute(&cus, hipDeviceAttributeMultiprocessorCount, dev);
        hipFuncSetAttribute((const void*)fwd_megakernel, hipFuncAttributeMaxDynamicSharedMemorySize, LDS_BYTES);
        hipOccupancyMaxActiveBlocksPerMultiprocessor(&per_cu, (const void*)fwd_megakernel, 512, LDS_BYTES);
        if (per_cu < 1) per_cu = 1;
        grid = cus * 1;
        if (n_in != 46 || ws_size < 8 * UNIT) fprintf(stderr, "kernel_launch: unexpected n_in %d / ws_size %zu\n", n_in, ws_size);
    }
    Params p{};
    for (int i = 0; i < 46; ++i) p.in[i] = (const float*)d_in[i];
    p.x = (float*)d_out; p.ws = (unsigned char*)d_ws; p.ph_lo = 0; p.ph_hi = 1000;
    hipMemsetAsync((char*)d_ws + BAR_OFF, 0, 16384, stream);
    void* args[] = {&p};
    hipError_t e = hipLaunchCooperativeKernel((const void*)fwd_megakernel, dim3(grid), dim3(512), args, LDS_BYTES, stream);
    if (e != hipSuccess) fprintf(stderr, "cooperative launch failed: %s (grid %d)\n", hipGetErrorString(e), grid);
}
```
